# Optimizing an MI355X kernel written in HIP

```python
import jax
import jax.numpy as jnp
from jax import lax
import numpy as np

D_MODEL = 1024
BATCH = 4
SEQ = 4096
DEPTH = 1

ATT_HEADS = 8
ATT_KV_HEADS = 2
ATT_GROUP = ATT_HEADS // ATT_KV_HEADS
ATT_HEAD_DIM = 64
WINDOW = 128
ATT_BLOCK = 128
ROPE_THETA = 500000.0
ROPE_DIM = ATT_HEAD_DIM // 4

DN_HEADS = 4
DN_KEY_DIM = 128
DN_VAL_DIM = 128
DN_CONV = 4
DN_CHUNK = 64

ATT_Q_W = ATT_HEADS * ATT_HEAD_DIM
ATT_KV_W = ATT_KV_HEADS * ATT_HEAD_DIM
DN_QK_W = DN_HEADS * DN_KEY_DIM
DN_V_W = DN_HEADS * DN_VAL_DIM
DN_QKV_W = 2 * DN_QK_W + DN_V_W
MIX_W = ATT_Q_W + DN_V_W
IN_W = ATT_Q_W + 2 * ATT_KV_W + DN_QKV_W + DN_V_W + 2 * DN_HEADS
IN_SPLITS = (ATT_Q_W,
             ATT_Q_W + ATT_KV_W,
             ATT_Q_W + 2 * ATT_KV_W,
             ATT_Q_W + 2 * ATT_KV_W + DN_QKV_W,
             ATT_Q_W + 2 * ATT_KV_W + DN_QKV_W + DN_V_W,
             ATT_Q_W + 2 * ATT_KV_W + DN_QKV_W + DN_V_W + DN_HEADS)

PEER_HEADS = 8
PEER_KEYS = 128
PEER_EXPERTS = PEER_KEYS * PEER_KEYS
PEER_QDIM = 256
PEER_HALF = PEER_QDIM // 2
PEER_TOPK = 16
PEER_TOKEN_BLOCK = 128

EPS = 1e-6

kernel_name = "hybrid_swa_sink_gdn_peer"


def rms_norm(x, w):
    xf = x.astype(jnp.float32)
    y = xf * lax.rsqrt(jnp.mean(xf * xf, axis=-1, keepdims=True) + EPS)
    return (y * w.astype(jnp.float32)).astype(x.dtype)


def l2_norm(x):
    return x * lax.rsqrt(jnp.sum(x * x, axis=-1, keepdims=True) + EPS)


def partial_rope(x, pos):
    half = ROPE_DIM // 2
    inv_freq = ROPE_THETA ** (-(jnp.arange(half, dtype=jnp.float32) * 2.0 / ROPE_DIM))
    ang = pos.astype(jnp.float32)[:, None] * inv_freq[None, :]
    cos = jnp.cos(ang)[None, :, None, :]
    sin = jnp.sin(ang)[None, :, None, :]
    xr = x[..., :ROPE_DIM].astype(jnp.float32)
    x1, x2 = xr[..., :half], xr[..., half:]
    rot = jnp.concatenate([x1 * cos - x2 * sin, x2 * cos + x1 * sin], axis=-1)
    return jnp.concatenate([rot.astype(x.dtype), x[..., ROPE_DIM:]], axis=-1)


def sliding_window_sink_attention(q, k, v, sinks):
    B, T = q.shape[0], q.shape[1]
    nb = T // ATT_BLOCK
    qb = q.reshape(B, nb, ATT_BLOCK, ATT_KV_HEADS, ATT_GROUP, ATT_HEAD_DIM)

    def band(t):
        tb = t.reshape(B, nb, ATT_BLOCK, ATT_KV_HEADS, ATT_HEAD_DIM)
        prev = jnp.pad(tb, ((0, 0), (1, 0), (0, 0), (0, 0), (0, 0)))[:, :-1]
        return jnp.concatenate([prev, tb], axis=2)

    kb, vb = band(k), band(v)
    s = jnp.einsum('bnqhgd,bnkhd->bnhgqk', qb, kb,
                   preferred_element_type=jnp.float32) * (ATT_HEAD_DIM ** -0.5)
    qi = jnp.arange(ATT_BLOCK)[:, None]
    ki = jnp.arange(2 * ATT_BLOCK)[None, :]
    rel = qi + ATT_BLOCK - ki
    kpos = (jnp.arange(nb)[:, None, None] - 1) * ATT_BLOCK + ki[None]
    valid = (rel >= 0)[None] & (rel < WINDOW)[None] & (kpos >= 0)
    s = jnp.where(valid[None, :, None, None], s, -jnp.inf)
    sink = sinks.astype(jnp.float32).reshape(1, 1, ATT_KV_HEADS, ATT_GROUP, 1, 1)
    m = jnp.maximum(jnp.max(s, axis=-1, keepdims=True), sink)
    p = jnp.exp(s - m)
    probs = p / (jnp.sum(p, axis=-1, keepdims=True) + jnp.exp(sink - m))
    o = jnp.einsum('bnhgqk,bnkhd->bnqhgd', probs.astype(v.dtype), vb)
    return o.reshape(B, T, ATT_HEADS * ATT_HEAD_DIM)


def causal_silu_conv(x, w):
    C = x.shape[-1]
    y = lax.conv_general_dilated(x, w[:, None, :].astype(x.dtype), window_strides=(1,),
                                 padding=((DN_CONV - 1, 0),),
                                 dimension_numbers=('NWC', 'WIO', 'NWC'),
                                 feature_group_count=C)
    return jax.nn.silu(y)


def chunk_gated_delta_rule(q, k, v, g, beta):
    B, T, H, Dk = q.shape
    Dv = v.shape[-1]
    C = DN_CHUNK
    n = T // C
    f32 = jnp.float32
    q = l2_norm(q.astype(f32)) * (Dk ** -0.5)
    k = l2_norm(k.astype(f32))
    v = v.astype(f32)

    def to_chunks(t):
        return jnp.swapaxes(t.reshape((B, n, C) + t.shape[2:]), 2, 3)

    q, k, v, g, beta = to_chunks(q), to_chunks(k), to_chunks(v), to_chunks(g), to_chunks(beta)
    g = jnp.cumsum(g, axis=-1)
    tril = jnp.tril(jnp.ones((C, C), dtype=bool))
    strict = jnp.tril(jnp.ones((C, C), dtype=bool), -1)
    diff = g[..., :, None] - g[..., None, :]
    decay = jnp.where(tril, jnp.exp(jnp.where(tril, diff, 0.0)), 0.0)
    k_beta = k * beta[..., None]
    v_beta = v * beta[..., None]
    L = jnp.where(strict, jnp.einsum('bnhid,bnhjd->bnhij', k_beta, k) * decay, 0.0)
    eye = jnp.eye(C, dtype=f32)
    t_mat = lax.linalg.triangular_solve(eye + L, jnp.broadcast_to(eye, L.shape),
                                        left_side=True, lower=True, unit_diagonal=True)
    u = t_mat @ v_beta
    w = t_mat @ (k_beta * jnp.exp(g)[..., None])
    intra = jnp.where(tril, jnp.einsum('bnhid,bnhjd->bnhij', q, k) * decay, 0.0)
    q_dec = q * jnp.exp(g)[..., None]
    k_dec = k * jnp.exp(g[..., -1:] - g)[..., None]
    g_last = jnp.exp(g[..., -1])

    def step(S, inp):
        intra_c, qd, kd, u_c, w_c, gl = inp
        v_new = u_c - w_c @ S
        o = qd @ S + intra_c @ v_new
        S = S * gl[..., None, None] + jnp.swapaxes(kd, -1, -2) @ v_new
        return S, o

    xs = (jnp.moveaxis(intra, 1, 0), jnp.moveaxis(q_dec, 1, 0), jnp.moveaxis(k_dec, 1, 0),
          jnp.moveaxis(u, 1, 0), jnp.moveaxis(w, 1, 0), jnp.moveaxis(g_last, 1, 0))
    S0 = jnp.zeros((B, H, Dk, Dv), f32)
    _, o = lax.scan(step, S0, xs)
    o = jnp.swapaxes(jnp.moveaxis(o, 0, 1), 2, 3)
    return o.reshape(B, T, H, Dv)


def peer(h, w_query, sub_keys1, sub_keys2, expert_down, expert_up):
    B, T, D = h.shape
    N = B * T
    hf = h.reshape(N, D)
    qry = (hf @ w_query).reshape(N, PEER_HEADS, 2, PEER_HALF)
    s1 = jnp.einsum('nhc,kc->nhk', qry[:, :, 0], sub_keys1, preferred_element_type=jnp.float32)
    s2 = jnp.einsum('nhc,kc->nhk', qry[:, :, 1], sub_keys2, preferred_element_type=jnp.float32)
    v1, i1 = lax.top_k(s1, PEER_TOPK)
    v2, i2 = lax.top_k(s2, PEER_TOPK)
    cand = (v1[..., :, None] + v2[..., None, :]).reshape(N, PEER_HEADS, PEER_TOPK * PEER_TOPK)
    cand_idx = (i1[..., :, None] * PEER_KEYS + i2[..., None, :]).reshape(
        N, PEER_HEADS, PEER_TOPK * PEER_TOPK)
    top_s, sel = lax.top_k(cand, PEER_TOPK)
    idx = jnp.take_along_axis(cand_idx, sel, axis=-1)
    gates = jax.nn.softmax(top_s, axis=-1)
    hk = PEER_HEADS * PEER_TOPK
    nb = N // PEER_TOKEN_BLOCK

    def block(args):
        xb, ib, gb = args
        u = jnp.take(expert_down, ib, axis=0)
        act = jax.nn.gelu(jnp.einsum('td,tkd->tk', xb, u), approximate=False)
        vsel = jnp.take(expert_up, ib, axis=0)
        return jnp.einsum('tk,tkd->td', (gb * act).astype(xb.dtype), vsel)

    out = lax.map(block, (hf.reshape(nb, PEER_TOKEN_BLOCK, D),
                          idx.reshape(nb, PEER_TOKEN_BLOCK, hk),
                          gates.reshape(nb, PEER_TOKEN_BLOCK, hk)))
    return out.reshape(B, T, D)


def setup_inputs(seed: int = 0):
    key = jax.random.key(seed)
    ks = jax.random.split(key, 17)
    f32 = jnp.float32

    def nrm(k, shape, scale):
        return jax.random.normal(k, shape, f32) * scale

    def gain(k, shape):
        return 1.0 + 0.02 * jax.random.normal(k, shape, f32)

    return {
        'x': nrm(ks[0], (BATCH, SEQ, D_MODEL), 1.0),
        'norm1_w': gain(ks[1], (DEPTH, D_MODEL)),
        'w_in': nrm(ks[2], (DEPTH, D_MODEL, IN_W), D_MODEL ** -0.5),
        'att_q_norm': gain(ks[3], (DEPTH, ATT_HEAD_DIM)),
        'att_k_norm': gain(ks[4], (DEPTH, ATT_HEAD_DIM)),
        'att_sinks': nrm(ks[5], (DEPTH, ATT_HEADS), 0.5),
        'dn_conv_w': nrm(ks[6], (DEPTH, DN_CONV, DN_QKV_W), DN_CONV ** -0.5),
        'dn_A_log': jnp.log(jax.random.uniform(ks[7], (DEPTH, DN_HEADS), f32, 1.0, 16.0)),
        'dn_dt_bias': 1.0 + 0.1 * jax.random.normal(ks[8], (DEPTH, DN_HEADS), f32),
        'dn_out_norm': gain(ks[9], (DEPTH, DN_VAL_DIM)),
        'w_out': nrm(ks[10], (DEPTH, MIX_W, D_MODEL), MIX_W ** -0.5),
        'norm2_w': gain(ks[11], (DEPTH, D_MODEL)),
        'peer_w_query': nrm(ks[12], (DEPTH, D_MODEL, PEER_HEADS * PEER_QDIM), D_MODEL ** -0.5),
        'peer_sub_keys1': nrm(ks[13], (DEPTH, PEER_KEYS, PEER_HALF), PEER_HALF ** -0.5),
        'peer_sub_keys2': nrm(ks[14], (DEPTH, PEER_KEYS, PEER_HALF), PEER_HALF ** -0.5),
        'peer_expert_down': nrm(ks[15], (DEPTH, PEER_EXPERTS, D_MODEL), D_MODEL ** -0.5),
        'peer_expert_up': nrm(ks[16], (DEPTH, PEER_EXPERTS, D_MODEL), PEER_HEADS ** -0.5),
    }


def reference(x, norm1_w, w_in, att_q_norm, att_k_norm, att_sinks, dn_conv_w, dn_A_log,
              dn_dt_bias, dn_out_norm, w_out, norm2_w, peer_w_query, peer_sub_keys1,
              peer_sub_keys2, peer_expert_down, peer_expert_up):
    B, T, _ = x.shape
    pos = jnp.arange(T)
    for l in range(DEPTH):
        h = rms_norm(x, norm1_w[l])
        proj = h @ w_in[l]
        a_q, a_k, a_v, d_qkv, d_gate, d_b, d_a = jnp.split(proj, IN_SPLITS, axis=-1)

        q = a_q.reshape(B, T, ATT_HEADS, ATT_HEAD_DIM)
        k = a_k.reshape(B, T, ATT_KV_HEADS, ATT_HEAD_DIM)
        v = a_v.reshape(B, T, ATT_KV_HEADS, ATT_HEAD_DIM)
        q = partial_rope(rms_norm(q, att_q_norm[l]), pos)
        k = partial_rope(rms_norm(k, att_k_norm[l]), pos)
        att_out = sliding_window_sink_attention(q, k, v, att_sinks[l])

        d_qkv = causal_silu_conv(d_qkv, dn_conv_w[l])
        dq, dk, dv = jnp.split(d_qkv, (DN_QK_W, 2 * DN_QK_W), axis=-1)
        beta = jax.nn.sigmoid(d_b.astype(jnp.float32))
        g = -jnp.exp(dn_A_log[l].astype(jnp.float32)) * jax.nn.softplus(
            d_a.astype(jnp.float32) + dn_dt_bias[l].astype(jnp.float32))
        o = chunk_gated_delta_rule(dq.reshape(B, T, DN_HEADS, DN_KEY_DIM),
                                   dk.reshape(B, T, DN_HEADS, DN_KEY_DIM),
                                   dv.reshape(B, T, DN_HEADS, DN_VAL_DIM), g, beta)
        o = rms_norm(o, dn_out_norm[l]) * jax.nn.silu(
            d_gate.reshape(B, T, DN_HEADS, DN_VAL_DIM).astype(jnp.float32))
        dn_out = o.reshape(B, T, DN_V_W).astype(x.dtype)

        x = x + jnp.concatenate([att_out, dn_out], axis=-1) @ w_out[l]

        x = x + peer(rms_norm(x, norm2_w[l]), peer_w_query[l], peer_sub_keys1[l],
                     peer_sub_keys2[l], peer_expert_down[l], peer_expert_up[l])
    return x
```

```cpp
#include <hip/hip_runtime.h>
#include <stdint.h>
#include <stdio.h>

#ifndef N_LAUNCH_PER_PHASE
#define N_LAUNCH_PER_PHASE 0
#endif

#define DI __device__ __forceinline__
#define LAS __attribute__((address_space(3)))
typedef unsigned short bf16_t;
typedef short bf16x8 __attribute__((ext_vector_type(8)));
typedef short bf16x4 __attribute__((ext_vector_type(4)));
typedef float f32x2 __attribute__((ext_vector_type(2)));
typedef float f32x4 __attribute__((ext_vector_type(4)));
typedef float f32x16 __attribute__((ext_vector_type(16)));
typedef unsigned u32x2 __attribute__((ext_vector_type(2)));
typedef unsigned u32x4 __attribute__((ext_vector_type(4)));
typedef int i32x4 __attribute__((ext_vector_type(4)));

constexpr int NTOK = 16384, DM = 1024, SEQ = 4096;
constexpr int INW = 2824, NPROJ = 2816;
constexpr int NTHR = 512;
constexpr float EPS = 1e-6f;

constexpr size_t MiB = 1u << 20;
constexpr size_t WS_BAR = 0;
constexpr size_t WS_KEYS = 128 * 1024;
constexpr size_t WS_ROPE = 256 * 1024;
constexpr size_t WS_RSTD1 = 512 * 1024;
constexpr size_t WS_RSTD2 = 576 * 1024;
constexpr size_t WS_GL = 640 * 1024;
constexpr size_t WS_WINT = 2 * MiB;
constexpr size_t WS_WOUTT = 8 * MiB;
constexpr size_t WS_WQT = 10 * MiB;
constexpr size_t WS_GATE = 14 * MiB;
constexpr size_t WS_R1 = 16 * MiB;
constexpr size_t WS_R2 = 48 * MiB;
constexpr size_t WS_R3 = 72 * MiB;
constexpr size_t WS_R4 = 120 * MiB;
constexpr size_t WS_R5 = 136 * MiB;
constexpr size_t WS_R6 = 156 * MiB;
constexpr size_t WS_H2B = WS_R6;
constexpr size_t WS_DNT = 104 * MiB;
constexpr size_t WS_UPT = 228 * MiB;
constexpr size_t WS_QRY = 40 * MiB;
constexpr size_t WS_IDX = 120 * MiB;
constexpr size_t WS_GATES = 128 * MiB;
constexpr size_t WS_END = 244 * MiB;
constexpr int DN_UNIT_BYTES = 73728;
constexpr int LDS_BYTES = 144 * 1024;
constexpr float PEER_SC_D = 256.0f, PEER_SC_U = 64.0f;
constexpr size_t PEER_SLICE = 16384 * 128;

DI unsigned f2bf(float f) { unsigned u = __float_as_uint(f); return (u + 0x7fffu + ((u >> 16) & 1u)) >> 16; }
typedef __bf16 bf16x2_t __attribute__((ext_vector_type(2)));
DI unsigned pk2(float lo, float hi) { const f32x2 v = {lo, hi}; return __builtin_bit_cast(unsigned, __builtin_convertvector(v, bf16x2_t)); }
DI float bflo(unsigned w) { return __uint_as_float(w << 16); }
DI float bfhi(unsigned w) { return __uint_as_float(w & 0xffff0000u); }
DI float bf2f(bf16_t h) { return __uint_as_float(((unsigned)h) << 16); }
DI float wave_sum(float v) {
#pragma unroll
    for (int o = 32; o > 0; o >>= 1) v += __shfl_xor(v, o);
    return v;
}
template <int CTRL> DI float dppf(float v) { return __int_as_float(__builtin_amdgcn_update_dpp(0, __float_as_int(v), CTRL, 0xf, 0xf, true)); }
DI float wave_sum_dpp(float v) {
    v += dppf<0xB1>(v);
    v += dppf<0x4E>(v);
    v += dppf<0x141>(v);
    v += dppf<0x140>(v);
    const int iv = __float_as_int(v);
    return (__int_as_float(__builtin_amdgcn_readlane(iv, 0)) + __int_as_float(__builtin_amdgcn_readlane(iv, 16))) + (__int_as_float(__builtin_amdgcn_readlane(iv, 32)) + __int_as_float(__builtin_amdgcn_readlane(iv, 48)));
}
DI f32x4 mfma16(bf16x8 a, bf16x8 b, f32x4 c) { return __builtin_amdgcn_mfma_f32_16x16x32_bf16(a, b, c, 0, 0, 0); }
DI f32x16 mfma32(bf16x8 a, bf16x8 b, f32x16 c) { return __builtin_amdgcn_mfma_f32_32x32x16_bf16(a, b, c, 0, 0, 0); }
DI bf16x8 pack8(f32x4 a, f32x4 b) {
    u32x4 p; p.x = pk2(a[0], a[1]); p.y = pk2(a[2], a[3]); p.z = pk2(b[0], b[1]); p.w = pk2(b[2], b[3]);
    return __builtin_bit_cast(bf16x8, p);
}
DI bf16x8 cat8(u32x2 a, u32x2 b) { u32x4 p; p.x = a.x; p.y = a.y; p.z = b.x; p.w = b.y; return __builtin_bit_cast(bf16x8, p); }
DI int opaque_tid() { int t = threadIdx.x; asm volatile("" : "+v"(t)); return t; }
DI __amdgpu_buffer_rsrc_t wt_rsrc(const void* base) { return __builtin_amdgcn_make_buffer_rsrc((void*)base, 0, 0x7fffffff, 0x00020000); }
DI void wt_store16(__amdgpu_buffer_rsrc_t r, unsigned byte_off, u32x4 v) { __builtin_amdgcn_raw_buffer_store_b128(v, r, byte_off, 0, 16); }
DI float sigmoidf_(float x) { return __builtin_amdgcn_rcpf(1.0f + __expf(-x)); }
DI float siluf_(float x) { return x * __builtin_amdgcn_rcpf(1.0f + __expf(-x)); }

#define XB_TMO      128
#define XB_XCNT(j)  (256  + 64 * (j))
#define XB_XSUB(j)  (1280 + 64 * (j))
#define XB_XGEN(j)  (2304 + 64 * (j))
#define XB_TOP      3328
#define XB_TOPGEN   3392
#define XCD_BAR_WORDS 3456
#define XB_SPIN_CAP (1u << 22)
DI unsigned xb_ld(unsigned* p)              { return __hip_atomic_load(p, __ATOMIC_RELAXED, __HIP_MEMORY_SCOPE_AGENT); }
DI unsigned xb_add(unsigned* p, unsigned v) { return __hip_atomic_fetch_add(p, v, __ATOMIC_RELAXED, __HIP_MEMORY_SCOPE_AGENT); }
DI unsigned xb_xcc_id() { return (unsigned)__builtin_amdgcn_s_getreg((3 << 11) | 20) & 0xFu; }
#define XB_SPIN(cond, bar) do { unsigned _sp = 0; while (cond) { if (_sp < 64u) __builtin_amdgcn_s_sleep(2); else __builtin_amdgcn_s_sleep(24); \
    if ((++_sp & 255u) == 0u) { if (xb_ld(&(bar)[XB_TMO])) break; if (_sp > XB_SPIN_CAP) { atomicAdd(&(bar)[XB_TMO], 1u); break; } } } } while (0)
struct XcdBarrier { unsigned* bar; unsigned x; volatile LAS unsigned* st; };
DI XcdBarrier xcd_barrier_post(unsigned* bar, volatile LAS unsigned* st) {
    XcdBarrier b; b.bar = bar; b.x = xb_xcc_id(); b.st = st;
    if (threadIdx.x == 0) (void)xb_add(&bar[XB_XCNT(b.x)], 1u);
    return b;
}
DI void xcd_barrier_complete(unsigned* bar, unsigned x, unsigned& nloc, unsigned& nx) {
    const unsigned G = gridDim.x * gridDim.y * gridDim.z;
    unsigned sum, cnt, mine, sp = 0u;
    for (;;) {
        sum = 0u; cnt = 0u; mine = 0u;
#pragma unroll
        for (unsigned j = 0; j < 16; ++j) { const unsigned c = xb_ld(&bar[XB_XCNT(j)]); sum += c; cnt += (c > 0u) ? 1u : 0u; mine = (j == x) ? c : mine; }
        if (sum == G) break;
        __builtin_amdgcn_s_sleep(1);
        if ((++sp & 255u) == 0u) { if (xb_ld(&bar[XB_TMO])) break; if (sp > XB_SPIN_CAP) { atomicAdd(&bar[XB_TMO], 1u); break; } }
    }
    nloc = mine > 0u ? mine : 1u; nx = cnt > 0u ? cnt : 1u;
}
DI void xcd_barrier(const XcdBarrier& b) {
    asm volatile("s_waitcnt vmcnt(0)" ::: "memory");
    __syncthreads();
    if (threadIdx.x == 0) {
        unsigned* bar = b.bar;
        __builtin_amdgcn_s_waitcnt(0);
        unsigned nloc = b.st[0], nx = b.st[1];
        if (nloc == 0u) { xcd_barrier_complete(bar, b.x, nloc, nx); b.st[0] = nloc; b.st[1] = nx; }
        const unsigned old = xb_add(&bar[XB_XSUB(b.x)], 1u);
        const unsigned gen = old / nloc;
        if (old + 1u == (gen + 1u) * nloc) {
            __builtin_amdgcn_fence(__ATOMIC_RELEASE, "agent");
            asm volatile("s_waitcnt vmcnt(0)" ::: "memory");
            const unsigned og = xb_add(&bar[XB_TOP], 1u);
            const unsigned tg = og / nx;
            if (og + 1u == (tg + 1u) * nx) xb_add(&bar[XB_TOPGEN], 1u);
            else XB_SPIN(xb_ld(&bar[XB_TOPGEN]) == tg, bar);
            __builtin_amdgcn_fence(__ATOMIC_ACQUIRE, "agent");
            xb_add(&bar[XB_XGEN(b.x)], 1u);
            asm volatile("s_waitcnt vmcnt(0)" ::: "memory");
        } else {
            XB_SPIN(xb_ld(&bar[XB_XGEN(b.x)]) == gen, bar);
            __builtin_amdgcn_fence(__ATOMIC_ACQUIRE, "agent");
            asm volatile("s_waitcnt vmcnt(0)" ::: "memory");
        }
    }
    __syncthreads();
}

struct Args { const float* in[17]; float* out; unsigned char* ws; int ph_lo, ph_hi; };
enum { I_X = 0, I_N1W, I_WIN, I_QNW, I_KNW, I_SINK, I_CONVW, I_ALOG, I_DTB, I_DNNORM, I_WOUT, I_N2W, I_WQ, I_SK1, I_SK2, I_EDOWN, I_EUP };

DI void p0_transpose_item(const float* W, int ldw, const float* scale, bf16_t* WT, int kt, int nt, LAS float* tile, int lane) {
    float v[64];
    const float* src = W + (size_t)(kt * 64) * ldw + nt * 64 + lane;
#pragma unroll
    for (int r = 0; r < 64; ++r) v[r] = src[(size_t)r * ldw];
    if (scale) {
#pragma unroll
        for (int r = 0; r < 64; ++r) v[r] *= scale[kt * 64 + r];
    }
#pragma unroll
    for (int r = 0; r < 64; ++r) tile[r * 65 + lane] = v[r];
    const int kc = (lane & 7) * 8;
#pragma unroll
    for (int it = 0; it < 8; ++it) {
        const int n = (lane >> 3) + 8 * it;
        u32x4 w;
        w.x = pk2(tile[(kc + 0) * 65 + n], tile[(kc + 1) * 65 + n]);
        w.y = pk2(tile[(kc + 2) * 65 + n], tile[(kc + 3) * 65 + n]);
        w.z = pk2(tile[(kc + 4) * 65 + n], tile[(kc + 5) * 65 + n]);
        w.w = pk2(tile[(kc + 6) * 65 + n], tile[(kc + 7) * 65 + n]);
        *(u32x4*)(WT + (size_t)(nt * 64 + n) * 1024 + kt * 64 + kc) = w;
    }
}

DI void sincos_d(double a, double& s, double& c) {
    const double TWO_OVER_PI = 0.63661977236758134308, PIO2_HI = 1.57079632679489655800e+00, PIO2_LO = 6.12323399573676603587e-17;
    const double q = __builtin_rint(a * TWO_OVER_PI);
    double r = (a - q * PIO2_HI) - q * PIO2_LO;
    const int qi = (int)q & 3;
    const double r2 = r * r;
    double sp = r * (1.0 + r2 * (-1.0 / 6 + r2 * (1.0 / 120 + r2 * (-1.0 / 5040 + r2 * (1.0 / 362880 + r2 * (-1.0 / 39916800 + r2 * (1.0 / 6227020800.0)))))));
    double cp = 1.0 + r2 * (-0.5 + r2 * (1.0 / 24 + r2 * (-1.0 / 720 + r2 * (1.0 / 40320 + r2 * (-1.0 / 3628800 + r2 * (1.0 / 479001600.0 + r2 * (-1.0 / 87178291200.0)))))));
    double ss = (qi & 1) ? cp : sp, cc = (qi & 1) ? sp : cp;
    if (qi == 1) { cc = -cc; } else if (qi == 2) { ss = -ss; cc = -cc; } else if (qi == 3) { ss = -ss; }
    s = ss; c = cc;
}

DI void phase_prep(const Args& a, LAS unsigned char* lds, int bid, int G) {
    const int tid = opaque_tid(), lane = tid & 63, wid = tid >> 6;
    unsigned char* ws = a.ws;
    {
        LAS float* tile = (LAS float*)(lds + wid * (64 * 65 * 4));
        for (int it = bid * 8 + wid; it < 704 + 256 + 512; it += G * 8) {
            if (it < 704) p0_transpose_item(a.in[I_WIN], INW, a.in[I_N1W], (bf16_t*)(ws + WS_WINT), it / 44, it % 44, tile, lane);
            else if (it < 960) { const int j = it - 704; p0_transpose_item(a.in[I_WOUT], 1024, nullptr, (bf16_t*)(ws + WS_WOUTT), j / 16, j % 16, tile, lane); }
            else { const int j = it - 960; p0_transpose_item(a.in[I_WQ], 2048, a.in[I_N2W], (bf16_t*)(ws + WS_WQT), j / 32, j % 32, tile, lane); }
        }
    }
    {
        const int g = bid * NTHR + tid;
        if (g < 32768) {
            bf16_t* keys = (bf16_t*)(ws + WS_KEYS);
            const float v = (g < 16384) ? a.in[I_SK1][g] : a.in[I_SK2][g - 16384];
            keys[g] = (bf16_t)f2bf(v);
            const int pos = g >> 3, i = g & 7;
            const float inv_freq = powf(500000.0f, -((float)i * 2.0f / 16.0f));
            const float ang = (float)pos * inv_freq;
            double s, c; sincos_d((double)ang, s, c);
            float* rc = (float*)(ws + WS_ROPE);
            rc[g] = (float)c; rc[32768 + g] = (float)s;
        }
    }
    {
        LAS float* wg = (LAS float*)lds;
        __syncthreads();
        for (int e = tid; e < 8192; e += NTHR) { const int k = e >> 3, j = e & 7; wg[j * 1024 + k] = a.in[I_N1W][k] * a.in[I_WIN][(size_t)k * INW + NPROJ + j]; }
        __syncthreads();
        const float* x = a.in[I_X];
        bf16_t* xb = (bf16_t*)(ws + WS_R1);
        float* rstd1 = (float*)(ws + WS_RSTD1);
        float* gate = (float*)(ws + WS_GATE);
        float* ssq = (float*)(ws + WS_RSTD2);
        const int tstride = G * 8;
        f32x4 v[2][4], vnx[2][4];
        int tok = bid * 8 + wid;
#pragma unroll
        for (int k = 0; k < 2; ++k) { const int t = tok + k * tstride, tc = t < NTOK ? t : tok;
#pragma unroll
            for (int i = 0; i < 4; ++i) v[k][i] = ((const f32x4*)(x + (size_t)tc * DM))[lane + 64 * i]; }
        for (; tok < NTOK; tok += 2 * tstride) {
            const int tn = tok + 2 * tstride;
            if (tn < NTOK) {
#pragma unroll
                for (int k = 0; k < 2; ++k) { const int t = tn + k * tstride, tc = t < NTOK ? t : tn;
#pragma unroll
                    for (int i = 0; i < 4; ++i) vnx[k][i] = ((const f32x4*)(x + (size_t)tc * DM))[lane + 64 * i]; }
            }
#pragma unroll
            for (int k = 0; k < 2; ++k) {
                const int t = tok + k * tstride;
                float ss = 0.f, d[8];
#pragma unroll
                for (int j = 0; j < 8; ++j) d[j] = 0.f;
#pragma unroll
                for (int i = 0; i < 4; ++i) {
                    ss += v[k][i][0] * v[k][i][0] + v[k][i][1] * v[k][i][1] + v[k][i][2] * v[k][i][2] + v[k][i][3] * v[k][i][3];
#pragma unroll
                    for (int j = 0; j < 8; ++j) { const f32x4 w = *(const LAS f32x4*)(wg + j * 1024 + 4 * (lane + 64 * i)); d[j] += v[k][i][0] * w[0] + v[k][i][1] * w[1] + v[k][i][2] * w[2] + v[k][i][3] * w[3]; }
                }
                ss = wave_sum_dpp(ss);
#pragma unroll
                for (int j = 0; j < 8; ++j) d[j] = wave_sum_dpp(d[j]);
                const float rs = rsqrtf(ss * (1.0f / DM) + EPS);
                if (t < NTOK) {
#pragma unroll
                    for (int i = 0; i < 4; ++i) { u32x2 w; w.x = pk2(v[k][i][0], v[k][i][1]); w.y = pk2(v[k][i][2], v[k][i][3]); *(u32x2*)(xb + (size_t)t * DM + 4 * (lane + 64 * i)) = w; }
                    float dl = d[0];
#pragma unroll
                    for (int j = 1; j < 8; ++j) dl = (lane == j) ? d[j] : dl;
                    if (lane < 8) gate[t * 8 + lane] = rs * dl;
                    if (lane == 0) { rstd1[t] = rs; ssq[t] = 0.f; }
                }
            }
#pragma unroll
            for (int k = 0; k < 2; ++k)
#pragma unroll
                for (int i = 0; i < 4; ++i) v[k][i] = vnx[k][i];
        }
    }
}

namespace pg8 {
#define PG8_LAS __attribute__((address_space(3)))
typedef unsigned short bf16_t;
typedef short bf16x8 __attribute__((ext_vector_type(8)));
typedef float f32x4 __attribute__((ext_vector_type(4)));
typedef unsigned u32x4 __attribute__((ext_vector_type(4)));
constexpr int BM = 256, BK = 64, HALF = 128, HTB = HALF * BK * 2  , STAGE_BYTES = 8 * HTB, NXCD = 8, WGM = 8;

__host__ __device__ __forceinline__ int lds_byte(int r, int c) { const int st = (r >> 4) * 2 + (c >> 5), rr = r & 15, cc = c & 31, ob = rr * 64 + cc * 2; return st * 1024 + (ob ^ (((ob >> 9) & 1) << 5)); }
__host__ __device__ __forceinline__ void stage_rc(int b, int& R, int& C) { const int st = b / 1024, sb = b % 1024, swz = sb ^ (((sb >> 9) & 1) << 5); R = (st >> 1) * 16 + swz / 64; C = (st & 1) * 32 + (swz % 64) / 2; }
__host__ __device__ __forceinline__ int perm32(int rho) { const int n = rho >> 4, i = rho & 15; return 8 * (i >> 2) + 4 * n + (i & 3); }

struct Unit { int pm, pn; };
struct Gemm { const bf16_t* A; const bf16_t* Bt; int M, N, K; };

struct StaticOrder {
    int nM, nN, nwg, G, c;
    __host__ __device__ void init(int M, int N, int G_, int c_) { nM = M / BM; nN = N / BM; nwg = nM * nN; G = G_; c = c_; }
    __host__ __device__ bool next(int i, Unit& u) const {
        const long L = (long)i * G + c; if (L >= nwg) return false;
        int wgid = (int)L; { const int q = nwg / NXCD, r = nwg % NXCD, xcd = wgid % NXCD, off = wgid / NXCD; wgid = (xcd < r ? xcd * (q + 1) : r * (q + 1) + (xcd - r) * q) + off; }
        const int nig = WGM * nN, gid = wgid / nig, fm = gid * WGM, gsz = (nM - fm) < WGM ? (nM - fm) : WGM;
        u.pm = fm + ((wgid % nig) % gsz); u.pn = (wgid % nig) / gsz; return true;
    }
    __device__ __forceinline__ void a_ready(const Unit&) const {}
    __device__ __forceinline__ void done(const Unit&) const {}
};
__device__ __forceinline__ unsigned cvt_pk_bf16(float lo, float hi) { unsigned r; asm volatile("v_cvt_pk_bf16_f32 %0, %1, %2" : "=v"(r) : "v"(lo), "v"(hi)); return r; }
struct EpiProj {
    static constexpr bool PERM = true, AFTER_DRAIN = false;
    bf16_t* att; bf16_t* dqkv; bf16_t* gate; const float* rstd;
    __device__ __forceinline__ void operator()(const f32x4 (&acc)[2][2][4][2], const Unit& u, int wr, int wc, int fr, int fq) const {
        bf16_t* base; int ld, c0;
        if (u.pn < 3) { base = att; ld = 768; c0 = u.pn * 256; } else if (u.pn < 9) { base = dqkv; ld = 1536; c0 = (u.pn - 3) * 256; } else { base = gate; ld = 512; c0 = (u.pn - 9) * 256; }
        const int row0 = u.pm * BM + wr * 64 + fr, col0 = c0 + wc * 32 + 8 * fq;
        const __amdgpu_buffer_rsrc_t rs_out = wt_rsrc(base);
#pragma unroll
        for (int ai = 0; ai < 2; ++ai)
#pragma unroll
            for (int m = 0; m < 4; ++m) {
                const int row = row0 + ai * HALF + m * 16; const float rs = rstd[row];
                const unsigned boff = (unsigned)(((size_t)row * ld + col0) * 2);
#pragma unroll
                for (int bj = 0; bj < 2; ++bj) { const f32x4 v0 = acc[ai][bj][m][0] * rs, v1 = acc[ai][bj][m][1] * rs; u32x4 w; w.x = cvt_pk_bf16(v0[0], v0[1]); w.y = cvt_pk_bf16(v0[2], v0[3]); w.z = cvt_pk_bf16(v1[0], v1[1]); w.w = cvt_pk_bf16(v1[2], v1[3]);
                    wt_store16(rs_out, boff + bj * HALF * 2, w); }
            }
    }
};
struct EpiOut {
    static constexpr bool PERM = true, AFTER_DRAIN = false;
    const float* x; float* out; bf16_t* h2b; float* ssq;
    __device__ __forceinline__ void operator()(const f32x4 (&acc)[2][2][4][2], const Unit& u, int wr, int wc, int fr, int fq) const {
        const int row0 = u.pm * BM + wr * 64 + fr, col0 = u.pn * BM + wc * 32 + 8 * fq;
        const __amdgpu_buffer_rsrc_t rs_h2b = wt_rsrc(h2b);
#pragma unroll
        for (int ai = 0; ai < 2; ++ai)
#pragma unroll
            for (int m = 0; m < 4; ++m) {
                const size_t off = (size_t)(row0 + ai * HALF + m * 16) * 1024 + col0;
                float sq = 0.f;
#pragma unroll
                for (int bj = 0; bj < 2; ++bj) {
                    const f32x4 v0 = *(const f32x4*)(x + off + bj * HALF) + acc[ai][bj][m][0], v1 = *(const f32x4*)(x + off + bj * HALF + 4) + acc[ai][bj][m][1];
                    u32x4 w; w.x = cvt_pk_bf16(v0[0], v0[1]); w.y = cvt_pk_bf16(v0[2], v0[3]); w.z = cvt_pk_bf16(v1[0], v1[1]); w.w = cvt_pk_bf16(v1[2], v1[3]);
                    wt_store16(rs_h2b, (unsigned)((off + bj * HALF) * 2), w);
                    sq += (v0[0] * v0[0] + v0[1] * v0[1]) + (v0[2] * v0[2] + v0[3] * v0[3]) + (v1[0] * v1[0] + v1[1] * v1[1]) + (v1[2] * v1[2] + v1[3] * v1[3]);
                }
                sq += __shfl_xor(sq, 16); sq += __shfl_xor(sq, 32);
                if (fq == 0) atomicAdd(ssq + row0 + ai * HALF + m * 16, sq);
            }
    }
};
struct EpiQry {
    static constexpr bool PERM = true, AFTER_DRAIN = false;
    bf16_t* q;
    __device__ __forceinline__ void operator()(const f32x4 (&acc)[2][2][4][2], const Unit& u, int wr, int wc, int fr, int fq) const {
        const int row0 = u.pm * BM + wr * 64 + fr, col0 = u.pn * BM + wc * 32 + 8 * fq;
        const __amdgpu_buffer_rsrc_t rs_q = wt_rsrc(q);
#pragma unroll
        for (int ai = 0; ai < 2; ++ai)
#pragma unroll
            for (int m = 0; m < 4; ++m) {
                const unsigned boff = (unsigned)(((size_t)(row0 + ai * HALF + m * 16) * 2048 + col0) * 2);
#pragma unroll
                for (int bj = 0; bj < 2; ++bj) { const f32x4 v0 = acc[ai][bj][m][0], v1 = acc[ai][bj][m][1]; u32x4 w; w.x = cvt_pk_bf16(v0[0], v0[1]); w.y = cvt_pk_bf16(v0[2], v0[3]); w.z = cvt_pk_bf16(v1[0], v1[1]); w.w = cvt_pk_bf16(v1[2], v1[3]);
                    wt_store16(rs_q, boff + bj * HALF * 2, w); }
            }
    }
};
template <class Epi, class Sched, bool ALIGN_EPI = false, bool SP2 = false>
__device__ __forceinline__ void gemm_phase(PG8_LAS unsigned char* lds, const Gemm g, const Sched& S, const Epi& E) {
    const int tid = opaque_tid(), wid = __builtin_amdgcn_readfirstlane(tid >> 6), lane = tid & 63, wr = wid >> 2, wc = wid & 3, fr = lane & 15, fq = lane >> 4;
    const int K = g.K, nt = K / BK;
    unsigned voffA[2], voffB[2];
#pragma unroll
    for (int i = 0; i < 2; ++i) { int R, C; stage_rc(tid * 16 + i * 8192, R, C); const int Rb = Epi::PERM ? ((R & ~31) + perm32(R & 31)) : R;
        voffA[i] = (unsigned)(R * K + C) * 2u; voffB[i] = (unsigned)(Rb * K + C) * 2u; }
    const size_t kstep = (size_t)(BK * 2);
    const size_t hstep = (size_t)HALF * K * 2;
    const size_t tstep = 2 * hstep;
    const unsigned ldsw = (unsigned)wid * 1024u;
    const int aoff = lds_byte(wr * 64 + fr, fq * 8), boff = lds_byte(wc * 32 + fr, fq * 8);
#define PG8_SA(b, h) (((b) * 2 + (h)) * HTB)
#define PG8_SB(b, h) ((4 + (b) * 2 + (h)) * HTB)
#define PG8_STAGE(bufoff, gbase, voff) do { _Pragma("unroll") for (int _i = 0; _i < 2; ++_i) \
        __builtin_amdgcn_global_load_lds((const unsigned*)((const char*)(gbase) + (voff)[_i]), (PG8_LAS unsigned*)(lds + (bufoff) + ldsw + _i * 8192), 16, 0, 0); } while (0)
#define PG8_LDA(dst, b, h) do { _Pragma("unroll") for (int m = 0; m < 4; ++m) _Pragma("unroll") for (int k = 0; k < 2; ++k) dst[m][k] = *(const PG8_LAS bf16x8*)(lds + PG8_SA(b, h) + aoff + m * 2048 + k * 1024); } while (0)
#define PG8_LDB(dst, b, h) do { _Pragma("unroll") for (int n = 0; n < 2; ++n) _Pragma("unroll") for (int k = 0; k < 2; ++k) dst[n][k] = *(const PG8_LAS bf16x8*)(lds + PG8_SB(b, h) + boff + n * 2048 + k * 1024); } while (0)
#define PG8_MMA(ai, bj, At, Bt) do { __builtin_amdgcn_s_setprio(1); _Pragma("unroll") for (int m = 0; m < 4; ++m) _Pragma("unroll") for (int n = 0; n < 2; ++n) _Pragma("unroll") for (int k = 0; k < 2; ++k) \
        acc[ai][bj][m][n] = __builtin_amdgcn_mfma_f32_16x16x32_bf16(Bt[n][k], At[m][k], acc[ai][bj][m][n], 0, 0, 0); __builtin_amdgcn_s_setprio(0); } while (0)
#define PG8_WAIT_V(n) asm volatile("s_waitcnt vmcnt(" #n ")" ::: "memory")
#define PG8_WAIT_L(n) asm volatile("s_waitcnt lgkmcnt(" #n ")" ::: "memory")
#define PG8_BAR __builtin_amdgcn_s_barrier()
#define PG8_SCHED __builtin_amdgcn_sched_barrier(0)
    Unit cur, nxt; int ui = 0;
    if (!S.next(0, cur)) return;
    f32x4 acc[2][2][4][2];
#pragma unroll
    for (int a = 0; a < 2; ++a)
#pragma unroll
        for (int b = 0; b < 2; ++b)
#pragma unroll
            for (int m = 0; m < 4; ++m)
#pragma unroll
                for (int n = 0; n < 2; ++n) acc[a][b][m][n] = (f32x4){0.f, 0.f, 0.f, 0.f};
    bf16x8 At[4][2], B0[2][2], B1[2][2];
    const char* cA = (const char*)g.A + (size_t)cur.pm * tstep; const char* cB = (const char*)g.Bt + (size_t)cur.pn * tstep;
    S.a_ready(cur);
    if constexpr (SP2) {
        PG8_STAGE(PG8_SB(0, 0), cB, voffB); PG8_STAGE(PG8_SB(0, 1), cB + hstep, voffB); PG8_STAGE(PG8_SA(0, 0), cA, voffA); PG8_STAGE(PG8_SA(0, 1), cA + hstep, voffA);
        if (wr == 1) PG8_BAR;
        PG8_WAIT_V(2); PG8_BAR;
        PG8_STAGE(PG8_SB(1, 0), cB + kstep, voffB); PG8_STAGE(PG8_SA(1, 0), cA + kstep, voffA); PG8_STAGE(PG8_SB(1, 1), cB + hstep + kstep, voffB);
        PG8_WAIT_V(6); PG8_BAR;
    } else {
        PG8_STAGE(PG8_SB(0, 0), cB, voffB); PG8_STAGE(PG8_SA(0, 0), cA, voffA); PG8_STAGE(PG8_SB(0, 1), cB + hstep, voffB); PG8_STAGE(PG8_SA(0, 1), cA + hstep, voffA);
        if (wr == 1) PG8_BAR;
        PG8_WAIT_V(4); PG8_BAR;
        PG8_STAGE(PG8_SB(1, 0), cB + kstep, voffB); PG8_STAGE(PG8_SA(1, 0), cA + kstep, voffA); PG8_STAGE(PG8_SB(1, 1), cB + hstep + kstep, voffB);
        PG8_WAIT_V(6); PG8_BAR;
    }
    for (;;) {
        const bool has_next = S.next(ui + 1, nxt);
        const char* nA = has_next ? (const char*)g.A + (size_t)nxt.pm * tstep : cA; const char* nB = has_next ? (const char*)g.Bt + (size_t)nxt.pn * tstep : cB;
        for (int t = 0; t < nt; t += 2) {
            const bool last = (t == nt - 2);
            const char* a1 = cA + (size_t)(t + 1) * kstep;
            const char* a2 = last ? nA : cA + (size_t)(t + 2) * kstep; const char* b2 = last ? nB : cB + (size_t)(t + 2) * kstep;
            const char* a3 = a2 + kstep; const char* b3 = b2 + kstep;
            if (last && has_next) S.a_ready(nxt);
            if constexpr (SP2) {
            PG8_LDB(B0, 0, 0); PG8_LDB(B1, 0, 1); PG8_SCHED; PG8_LDA(At, 0, 0); PG8_STAGE(PG8_SA(1, 1), a1 + hstep, voffA);
            PG8_WAIT_V(8); PG8_WAIT_L(0); PG8_BAR; PG8_MMA(0, 0, At, B0); PG8_MMA(0, 1, At, B1); PG8_BAR; PG8_SCHED;
            PG8_LDA(At, 0, 1); PG8_STAGE(PG8_SB(0, 0), b2, voffB); PG8_STAGE(PG8_SB(0, 1), b2 + hstep, voffB); PG8_STAGE(PG8_SA(0, 0), a2, voffA);
            PG8_WAIT_V(8); PG8_WAIT_L(0); PG8_BAR; PG8_MMA(1, 0, At, B0); PG8_MMA(1, 1, At, B1); PG8_BAR; PG8_SCHED;
            PG8_LDB(B0, 1, 0); PG8_LDB(B1, 1, 1); PG8_SCHED; PG8_LDA(At, 1, 0); PG8_STAGE(PG8_SA(0, 1), a2 + hstep, voffA);
            PG8_WAIT_V(8); PG8_WAIT_L(0); PG8_BAR; PG8_MMA(0, 0, At, B0); PG8_MMA(0, 1, At, B1); PG8_BAR; PG8_SCHED;
            PG8_LDA(At, 1, 1); PG8_STAGE(PG8_SB(1, 0), b3, voffB); PG8_STAGE(PG8_SB(1, 1), b3 + hstep, voffB); PG8_STAGE(PG8_SA(1, 0), a3, voffA);
            PG8_WAIT_V(8); PG8_WAIT_L(0); PG8_BAR; PG8_MMA(1, 0, At, B0); PG8_MMA(1, 1, At, B1); PG8_BAR; PG8_SCHED;
            } else {
            PG8_LDB(B0, 0, 0); PG8_SCHED; PG8_LDA(At, 0, 0); PG8_STAGE(PG8_SA(1, 1), a1 + hstep, voffA);
            PG8_WAIT_L(8); PG8_BAR; PG8_WAIT_L(0); PG8_MMA(0, 0, At, B0); PG8_BAR; PG8_SCHED;
            PG8_LDB(B1, 0, 1); PG8_STAGE(PG8_SB(0, 0), b2, voffB);
            PG8_BAR; PG8_WAIT_L(0); PG8_MMA(0, 1, At, B1); PG8_BAR;
            PG8_LDA(At, 0, 1); PG8_STAGE(PG8_SA(0, 0), a2, voffA);
            PG8_BAR; PG8_WAIT_L(0); PG8_MMA(1, 0, At, B0); PG8_BAR; PG8_SCHED;
            PG8_STAGE(PG8_SB(0, 1), b2 + hstep, voffB);
            PG8_WAIT_V(6); PG8_BAR; PG8_MMA(1, 1, At, B1); PG8_BAR;
            PG8_LDB(B0, 1, 0); PG8_SCHED; PG8_LDA(At, 1, 0); PG8_STAGE(PG8_SA(0, 1), a2 + hstep, voffA);
            PG8_WAIT_L(8); PG8_BAR; PG8_WAIT_L(0); PG8_MMA(0, 0, At, B0); PG8_BAR; PG8_SCHED;
            PG8_LDB(B1, 1, 1); PG8_STAGE(PG8_SB(1, 0), b3, voffB);
            PG8_BAR; PG8_WAIT_L(0); PG8_MMA(0, 1, At, B1); PG8_BAR;
            PG8_LDA(At, 1, 1); PG8_STAGE(PG8_SA(1, 0), a3, voffA);
            PG8_BAR; PG8_WAIT_L(0); PG8_MMA(1, 0, At, B0); PG8_BAR; PG8_SCHED;
            PG8_STAGE(PG8_SB(1, 1), b3 + hstep, voffB);
            PG8_WAIT_V(6); PG8_BAR; PG8_MMA(1, 1, At, B1); PG8_BAR;
            }
        }
        if constexpr (ALIGN_EPI) { if (wr == 0) PG8_BAR; }
        if constexpr (!Epi::AFTER_DRAIN) { E(acc, cur, wr, wc, fr, fq); S.done(cur); }
        if (!has_next) break;
#pragma unroll
        for (int a = 0; a < 2; ++a)
#pragma unroll
            for (int b = 0; b < 2; ++b)
#pragma unroll
                for (int m = 0; m < 4; ++m)
#pragma unroll
                    for (int n = 0; n < 2; ++n) acc[a][b][m][n] = (f32x4){0.f, 0.f, 0.f, 0.f};
        cur = nxt; cA = nA; cB = nB; ++ui;
        if constexpr (ALIGN_EPI) { if (wr == 1) PG8_BAR; }
    }
    PG8_WAIT_V(0);
    if constexpr (!ALIGN_EPI) { if (wr == 0) PG8_BAR; }
    PG8_BAR;
    if constexpr (Epi::AFTER_DRAIN) { E.fused(acc, cur, wr, wc, fr, fq, lds, wid, lane); S.done(cur); }
#undef PG8_SA
#undef PG8_SB
#undef PG8_STAGE
#undef PG8_LDA
#undef PG8_LDB
#undef PG8_MMA
#undef PG8_WAIT_V
#undef PG8_WAIT_L
#undef PG8_BAR
#undef PG8_SCHED
}
}

DI void phase_qknorm(const Args& a, int bid, int G) {
    const int tid = opaque_tid();
    unsigned char* ws = a.ws;
    const bf16_t* patt = (const bf16_t*)(ws + WS_R2);
    bf16_t* Qn = (bf16_t*)(ws + WS_R5);
    bf16_t* Kn = Qn + (size_t)NTOK * 512;
    const float* rc = (const float*)(ws + WS_ROPE);
    const int sub = tid & 15;
    const int stride = (G * NTHR) >> 4, NIT = NTOK * 10;
    f32x4 nwq, nwk;
    nwq = *(const f32x4*)(a.in[I_QNW] + 4 * sub); nwk = *(const f32x4*)(a.in[I_KNW] + 4 * sub);
    for (int item0 = (bid * NTHR + tid) >> 4; item0 < NIT; item0 += 4 * stride) {
        u32x2 raw[4];
#pragma unroll
        for (int k = 0; k < 4; ++k) {
            const int item = item0 + k * stride, ic = item < NIT ? item : item0;
            raw[k] = *(const u32x2*)(patt + (size_t)(ic / 10) * 768 + (ic % 10) * 64 + 4 * sub);
        }
#pragma unroll
        for (int k = 0; k < 4; ++k) {
            const int item = item0 + k * stride, ic = item < NIT ? item : item0;
            const int tok = ic / 10, hh = ic % 10, pos = tok & (SEQ - 1);
            float v[4] = {bflo(raw[k].x), bfhi(raw[k].x), bflo(raw[k].y), bfhi(raw[k].y)};
            float ss = v[0] * v[0] + v[1] * v[1] + v[2] * v[2] + v[3] * v[3];
            ss += dppf<0xB1>(ss); ss += dppf<0x4E>(ss); ss += dppf<0x141>(ss); ss += dppf<0x140>(ss);
            const float rs = rsqrtf(ss * (1.0f / 64.0f) + EPS);
            const f32x4 nw = (hh < 8) ? nwq : nwk;
            float y[4], p[4];
#pragma unroll
            for (int e = 0; e < 4; ++e) y[e] = v[e] * rs * nw[e];
#pragma unroll
            for (int e = 0; e < 4; ++e) p[e] = dppf<0x4E>(y[e]);
            if (sub < 4) {
                const f32x4 c4 = *(const f32x4*)(rc + pos * 8 + 4 * (sub & 1)), s4 = *(const f32x4*)(rc + 32768 + pos * 8 + 4 * (sub & 1));
#pragma unroll
                for (int e = 0; e < 4; ++e) y[e] = (sub < 2) ? (y[e] * c4[e] - p[e] * s4[e]) : (y[e] * c4[e] + p[e] * s4[e]);
            }
            const float sc = (hh < 8) ? 0.125f : 1.0f;
            u32x2 w; w.x = pk2(y[0] * sc, y[1] * sc); w.y = pk2(y[2] * sc, y[3] * sc);
            if (item < NIT) {
                if (hh < 8) *(u32x2*)(Qn + (size_t)tok * 512 + hh * 64 + 4 * sub) = w;
                else *(u32x2*)(Kn + (size_t)tok * 128 + (hh - 8) * 64 + 4 * sub) = w;
            }
        }
    }
}

constexpr int DP_ROW = 272;
constexpr int DP_IMG = 64 * DP_ROW;
constexpr int DP_HALF = 4 * DP_IMG;
constexpr int DP_SMALL = 2 * DP_HALF;
DI void phase_dnprep(const Args& a, LAS unsigned char* lds, int bid, int G) {
    unsigned char* ws = a.ws;
    const bf16_t* pd = (const bf16_t*)(ws + WS_R3);
    const float* gate = (const float*)(ws + WS_GATE);
    const float* cw = a.in[I_CONVW];
    for (int up = bid; up < 512; up += G) {
        int tid = threadIdx.x;
        asm volatile("" : "+v"(tid));
        const int half = tid >> 8, ht = tid & 255, lane = tid & 63, hw = ht >> 6, fr = lane & 15, fq = lane >> 4;
        LAS unsigned char* qs = lds + half * DP_HALF;
        LAS unsigned char* ks = qs + DP_IMG;
        LAS unsigned char* vs = ks + DP_IMG;
        LAS float* Lm = (LAS float*)(vs + DP_IMG);
        LAS float* gc = (LAS float*)(lds + DP_SMALL + half * 512);
        LAS float* bt = gc + 64;
        LAS float* fb = (LAS float*)(lds + DP_SMALL + 1024 + half * 256);
        LAS float* eg = (LAS float*)(lds + DP_SMALL + 1536 + half * 512);
        LAS float* ek = eg + 64;
        const int unit = up * 2 + half;
        const int n = unit & 63, h = (unit >> 6) & 3, b = unit >> 8;
        const int c0 = n * 64, tok0 = b * SEQ + c0;
        unsigned char* ub = ws + WS_R6 + (size_t)unit * DN_UNIT_BYTES;
        __syncthreads();
#ifndef DP_S1
#define DP_S1 1
#define DP_S2 1
#define DP_S3 1
#endif
#pragma unroll 1
        for (int r1_ = 0; r1_ < DP_S1; ++r1_) {
            unsigned raw[3][19];
#pragma unroll
            for (int which = 0; which < 3; ++which) {
                const int cb = which * 512 + h * 128 + 2 * lane;
#pragma unroll
                for (int r = 0; r < 19; ++r) {
                    const int t = c0 + 16 * hw - 3 + r;
                    raw[which][r] = (t >= 0) ? *(const unsigned*)(pd + (size_t)(b * SEQ + (t >= 0 ? t : 0)) * 1536 + cb) : 0u;
                }
            }
#pragma unroll
            for (int which = 0; which < 3; ++which) {
                const int cb = which * 512 + h * 128 + 2 * lane;
                float w0[4], w1[4];
#pragma unroll
                for (int j = 0; j < 4; ++j) { const f32x2 w = *(const f32x2*)(cw + j * 1536 + cb); w0[j] = w[0]; w1[j] = w[1]; }
                LAS unsigned char* img = qs + which * DP_IMG;
#pragma unroll
                for (int ii = 0; ii < 16; ++ii) {
                    float y0 = 0.f, y1 = 0.f;
#pragma unroll
                    for (int j = 0; j < 4; ++j) { y0 += w0[j] * bflo(raw[which][ii + j]); y1 += w1[j] * bfhi(raw[which][ii + j]); }
                    y0 = siluf_(y0); y1 = siluf_(y1);
                    if (which < 2) {
                        const float ss = wave_sum_dpp(y0 * y0 + y1 * y1);
                        float sc = rsqrtf(ss + EPS);
                        if (which == 0) sc *= 0.08838834764831845f;
                        y0 *= sc; y1 *= sc;
                    }
                    *(LAS unsigned*)(img + (16 * hw + ii) * DP_ROW + 4 * lane) = pk2(y0, y1);
                }
            }
        }
        if (hw == 0) {
            const float bb = gate[(size_t)(tok0 + lane) * 8 + h], aa = gate[(size_t)(tok0 + lane) * 8 + 4 + h];
            const float xx = aa + a.in[I_DTB][h];
            const float sp = (xx > 20.f) ? xx : log1pf(expf(xx));
            float g = -expf(a.in[I_ALOG][h]) * sp;
#pragma unroll
            for (int o = 1; o < 64; o <<= 1) { const float t = __shfl_up(g, o); if (lane >= o) g += t; }
            const float be = sigmoidf_(bb);
            const float eg_ = __expf(g), g63_ = __shfl(g, 63);
            gc[lane] = g; bt[lane] = be; fb[lane] = be * eg_; eg[lane] = eg_; ek[lane] = __expf(g63_ - g);
        }
        __syncthreads();
#pragma unroll 1
        for (int r2_ = 0; r2_ < DP_S2; ++r2_) {
            const int it = hw;
            const int i = 16 * it + fr;
            const float gi = gc[i], bi = bt[i];
            bf16_t* intra = (bf16_t*)(ub + 49152);
#pragma unroll
            for (int jp = 0; jp < 2; ++jp) {
                u32x4 wv;
#pragma unroll
                for (int jh = 0; jh < 2; ++jh) {
                    const int jt = 2 * jp + jh;
                    f32x4 akk = {0.f, 0.f, 0.f, 0.f}, aqk = {0.f, 0.f, 0.f, 0.f};
#pragma unroll
                    for (int s = 0; s < 4; ++s) {
                        const bf16x8 A = *(const LAS bf16x8*)(ks + (16 * jt + fr) * DP_ROW + s * 64 + fq * 16);
                        const bf16x8 Bk = *(const LAS bf16x8*)(ks + (16 * it + fr) * DP_ROW + s * 64 + fq * 16);
                        const bf16x8 Bq = *(const LAS bf16x8*)(qs + (16 * it + fr) * DP_ROW + s * 64 + fq * 16);
                        akk = mfma16(A, Bk, akk); aqk = mfma16(A, Bq, aqk);
                    }
                    f32x4 lv, iv;
#pragma unroll
                    for (int r = 0; r < 4; ++r) {
                        const int j = 16 * jt + 4 * fq + r;
                        const float dec = (j <= i) ? __expf(gi - gc[j]) : 0.f;
                        lv[r] = (j < i) ? bi * akk[r] * dec : 0.f;
                        iv[r] = aqk[r] * dec;
                    }
                    *(LAS f32x4*)(Lm + i * 68 + 16 * jt + 4 * fq) = lv;
                    if (jh == 0) { wv.x = pk2(iv[0], iv[1]); wv.y = pk2(iv[2], iv[3]); } else { wv.z = pk2(iv[0], iv[1]); wv.w = pk2(iv[2], iv[3]); }
                }
                *(u32x4*)(intra + i * 64 + 32 * jp + 8 * fq) = wv;
            }
        }
        __syncthreads();
        {
            const int j = lane & 15;
            const LAS float* Lb = Lm + (16 * hw) * 68 + 16 * hw;
            float t[16];
#pragma unroll
            for (int i = 0; i < 16; ++i) {
                float acc = (i == j) ? 1.f : 0.f;
#pragma unroll
                for (int k4 = 0; k4 < i; k4 += 4) {
                    const f32x4 l = *(const LAS f32x4*)(Lb + i * 68 + k4);
                    acc -= l[0] * t[k4];
                    if (k4 + 1 < i) acc -= l[1] * t[k4 + 1];
                    if (k4 + 2 < i) acc -= l[2] * t[k4 + 2];
                    if (k4 + 3 < i) acc -= l[3] * t[k4 + 3];
                }
                t[i] = acc;
            }
            asm volatile("s_waitcnt lgkmcnt(0)" ::: "memory");
#pragma unroll
            for (int i = 0; i < 16; ++i) *(LAS float*)(Lm + (16 * hw + i) * 68 + 16 * hw + j) = t[i];
        }
        __syncthreads();
        f32x4 U[4][4];
        {
            const LAS unsigned char* src = (hw < 2) ? (vs + 2 * (64 * hw)) : (ks + 2 * (64 * (hw - 2)));
            const LAS float* fac = (hw < 2) ? bt : fb;
            f32x4 R[4][4];
#pragma unroll
            for (int ct = 0; ct < 4; ++ct)
#pragma unroll
                for (int bb = 0; bb < 4; ++bb)
#pragma unroll
                    for (int r = 0; r < 4; ++r) { const int i = 16 * bb + 4 * fq + r; R[ct][bb][r] = bf2f(*(const LAS bf16_t*)(src + i * DP_ROW + 2 * (16 * ct + fr))) * fac[i]; }
            u32x2 Ub16[4][4];
#pragma unroll
            for (int bb = 0; bb < 4; ++bb) {
                f32x4 X[4];
#pragma unroll
                for (int ct = 0; ct < 4; ++ct) X[ct] = (f32x4){0.f, 0.f, 0.f, 0.f};
#pragma unroll
                for (int c = 0; c < bb; c += 2) {
                    const f32x4 a0 = *(const LAS f32x4*)(Lm + (16 * bb + fr) * 68 + 16 * c + 4 * fq);
                    f32x4 a1 = {0.f, 0.f, 0.f, 0.f};
                    if (c + 1 < bb) a1 = *(const LAS f32x4*)(Lm + (16 * bb + fr) * 68 + 16 * (c + 1) + 4 * fq);
                    const bf16x8 A = pack8(a0, a1);
#pragma unroll
                    for (int ct = 0; ct < 4; ++ct) {
                        const u32x2 z = {0u, 0u};
                        const bf16x8 B = cat8(Ub16[ct][c], (c + 1 < bb) ? Ub16[ct][c + 1] : z);
                        X[ct] = mfma16(A, B, X[ct]);
                    }
                }
                const f32x4 tv = *(const LAS f32x4*)(Lm + (16 * bb + fr) * 68 + 16 * bb + 4 * fq);
                const bf16x8 AT = pack8(tv, (f32x4){0.f, 0.f, 0.f, 0.f});
#pragma unroll
                for (int ct = 0; ct < 4; ++ct) {
                    const f32x4 Rp = R[ct][bb] - X[ct];
                    u32x2 rp16; rp16.x = pk2(Rp[0], Rp[1]); rp16.y = pk2(Rp[2], Rp[3]);
                    const u32x2 z = {0u, 0u};
                    const f32x4 Ub = mfma16(AT, cat8(rp16, z), (f32x4){0.f, 0.f, 0.f, 0.f});
                    U[ct][bb] = Ub;
                    Ub16[ct][bb].x = pk2(Ub[0], Ub[1]); Ub16[ct][bb].y = pk2(Ub[2], Ub[3]);
                }
            }
        }
        __syncthreads();
        LAS unsigned char* img_k = (LAS unsigned char*)Lm;
        {
            bf16_t* qd = (bf16_t*)(ub + 16384);
            const int c16 = ht & 15, cc = c16 >> 2, k = c16 & 3;
#pragma unroll
            for (int itr = 0; itr < 4; ++itr) {
                const int i = (ht >> 4) + 16 * itr;
                const float e = eg[i];
                const u32x2 r0 = *(const LAS u32x2*)(qs + i * DP_ROW + cc * 64 + k * 8), r1 = *(const LAS u32x2*)(qs + i * DP_ROW + cc * 64 + 32 + k * 8);
                u32x4 w;
                w.x = pk2(bflo(r0.x) * e, bfhi(r0.x) * e); w.y = pk2(bflo(r0.y) * e, bfhi(r0.y) * e);
                w.z = pk2(bflo(r1.x) * e, bfhi(r1.x) * e); w.w = pk2(bflo(r1.y) * e, bfhi(r1.y) * e);
                *(u32x4*)(qd + i * 128 + c16 * 8) = w;
            }
            const int d = ht & 127, ih = ht >> 7;
#pragma unroll
            for (int k2 = 0; k2 < 4; ++k2) {
                float v[8];
#pragma unroll
                for (int e2 = 0; e2 < 8; ++e2) { const int ii = 32 * ih + 16 * (e2 >> 2) + 4 * k2 + (e2 & 3); v[e2] = bf2f(*(const LAS bf16_t*)(ks + ii * DP_ROW + 2 * d)) * ek[ii]; }
                u32x4 w; w.x = pk2(v[0], v[1]); w.y = pk2(v[2], v[3]); w.z = pk2(v[4], v[5]); w.w = pk2(v[6], v[7]);
                *(LAS u32x4*)(img_k + d * 128 + (((4 * ih + k2) ^ (d & 7)) * 16)) = w;
            }
            if (ht == 0) ((float*)(ws + WS_GL))[unit] = eg[63];
            if (hw >= 2) {
#pragma unroll
                for (int ct = 0; ct < 4; ++ct) {
                    const int cc2 = 64 * (hw - 2) + 16 * ct + fr, cp = (cc2 & ~31) | (((cc2 >> 2) & 3) << 3) | (((cc2 >> 4) & 1) << 2) | (cc2 & 3);
#pragma unroll
                    for (int bb = 0; bb < 4; ++bb)
#pragma unroll
                        for (int r = 0; r < 4; ++r) *(LAS bf16_t*)(vs + (16 * bb + 4 * fq + r) * DP_ROW + 2 * cp) = (bf16_t)f2bf(U[ct][bb][r]);
                }
            }
        }
        __syncthreads();
        {
            if (hw < 2) {
#pragma unroll
                for (int ct = 0; ct < 4; ++ct) {
                    const int dv = 64 * hw + 16 * ct + fr;
#pragma unroll
                    for (int bb = 0; bb < 4; ++bb) {
                        u32x2 w; w.x = pk2(U[ct][bb][0], U[ct][bb][1]); w.y = pk2(U[ct][bb][2], U[ct][bb][3]);
                        *(LAS u32x2*)(qs + dv * 128 + (((2 * bb + (fq >> 1)) ^ (dv & 7)) * 16) + 8 * (fq & 1)) = w;
                    }
                }
            }
            bf16_t* kdT = (bf16_t*)(ub + 32768);
            bf16_t* wout = (bf16_t*)ub;
#pragma unroll
            for (int k = 0; k < 4; ++k) {
                const int cid = ht + 256 * k;
                { const int row = cid >> 3, c = cid & 7; *(u32x4*)(kdT + row * 64 + c * 8) = *(const LAS u32x4*)(img_k + row * 128 + ((c ^ (row & 7)) * 16)); }
                { const int row = cid >> 4, c16 = cid & 15; *(u32x4*)(wout + row * 128 + c16 * 8) = *(const LAS u32x4*)(vs + row * DP_ROW + c16 * 16); }
            }
        }
        __syncthreads();
        {
            bf16_t* uT = (bf16_t*)(ub + 57344);
#pragma unroll
            for (int k = 0; k < 4; ++k) {
                const int cid = ht + 256 * k, row = cid >> 3, c = cid & 7;
                *(u32x4*)(uT + row * 64 + c * 8) = *(const LAS u32x4*)(qs + row * 128 + ((c ^ (row & 7)) * 16));
            }
        }
    }
}

constexpr int AT_KROW = 144, AT_KSZ = 208 * AT_KROW;
constexpr int AT_VROW = 432;
DI void attn_unit(const Args& a, LAS unsigned char* lds, int unit) {
    const int tid = opaque_tid(), lane = tid & 63, wid = tid >> 6, fr = lane & 15, fq = lane >> 4;
    unsigned char* ws = a.ws;
    const bf16_t* Qn = (const bf16_t*)(ws + WS_R5);
    const bf16_t* Kn = Qn + (size_t)NTOK * 512;
    const bf16_t* patt = (const bf16_t*)(ws + WS_R2);
    bf16_t* mix = (bf16_t*)(ws + WS_R1);
    const int qh = unit & 1, hkv = (unit >> 1) & 1, blk = (unit >> 2) & 31, b = unit >> 7;
    const int Q0 = blk * 128 + qh * 64;
    LAS unsigned char* Ks = lds;
    LAS unsigned char* VT = lds + AT_KSZ;
    __syncthreads();
    for (int cid = tid; cid < 208 * 8; cid += NTHR) {
        const int kk = cid >> 3, c = cid & 7, key = Q0 - 128 + kk;
        u32x4 kv = {0u, 0u, 0u, 0u}, vv = {0u, 0u, 0u, 0u};
        if (key >= 0 && kk < 192) {
            kv = *(const u32x4*)(Kn + (size_t)(b * SEQ + key) * 128 + hkv * 64 + c * 8);
            vv = *(const u32x4*)(patt + (size_t)(b * SEQ + key) * 768 + 640 + hkv * 64 + c * 8);
        }
        *(LAS u32x4*)(Ks + kk * AT_KROW + c * 16) = kv;
        const unsigned vw[4] = {vv.x, vv.y, vv.z, vv.w};
#pragma unroll
        for (int e = 0; e < 4; ++e) {
            *(LAS bf16_t*)(VT + (c * 8 + 2 * e) * AT_VROW + 2 * kk) = (bf16_t)(vw[e] & 0xffffu);
            *(LAS bf16_t*)(VT + (c * 8 + 2 * e + 1) * AT_VROW + 2 * kk) = (bf16_t)(vw[e] >> 16);
        }
    }
    __syncthreads();
#pragma unroll 1
    for (int it = 0; it < 2; ++it) {
        const int wu = wid + 8 * it, g = wu & 3, i4 = wu >> 2, h = hkv * 4 + g;
        const int qpos = Q0 + 16 * i4 + fr;
        const size_t tok = (size_t)b * SEQ + qpos;
        bf16x8 bq[2];
#pragma unroll
        for (int s = 0; s < 2; ++s) bq[s] = *(const bf16x8*)(Qn + tok * 512 + h * 64 + 32 * s + 8 * fq);
        const float sink = a.in[I_SINK][h];
        f32x4 sc[10];
        float mx = -3.0e38f;
#pragma unroll
        for (int t = 0; t < 10; ++t) {
            f32x4 acc = {0.f, 0.f, 0.f, 0.f};
#pragma unroll
            for (int s = 0; s < 2; ++s) { const bf16x8 A = *(const LAS bf16x8*)(Ks + (16 * (i4 + t) + fr) * AT_KROW + s * 64 + fq * 16); acc = mfma16(A, bq[s], acc); }
#pragma unroll
            for (int r = 0; r < 4; ++r) {
                const int kpos = Q0 - 128 + 16 * (i4 + t) + 4 * fq + r;
                const bool valid = (kpos >= 0) && (kpos <= qpos) && (kpos >= qpos - 127);
                acc[r] = valid ? acc[r] : -3.0e38f;
                mx = fmaxf(mx, acc[r]);
            }
            sc[t] = acc;
        }
        mx = fmaxf(mx, __shfl_xor(mx, 16)); mx = fmaxf(mx, __shfl_xor(mx, 32));
        mx = fmaxf(mx, sink);
        float sum = 0.f;
#pragma unroll
        for (int t = 0; t < 10; ++t)
#pragma unroll
            for (int r = 0; r < 4; ++r) { const float p = (sc[t][r] > -1.0e38f) ? __expf(sc[t][r] - mx) : 0.f; sc[t][r] = p; sum += p; }
        sum += __shfl_xor(sum, 16); sum += __shfl_xor(sum, 32);
        const float inv = 1.0f / (sum + __expf(sink - mx));
        bf16x8 bp[5];
#pragma unroll
        for (int kp = 0; kp < 5; ++kp) bp[kp] = pack8(sc[2 * kp], sc[2 * kp + 1]);
#pragma unroll
        for (int mt = 0; mt < 4; ++mt) {
            f32x4 o = {0.f, 0.f, 0.f, 0.f};
#pragma unroll
            for (int kp = 0; kp < 5; ++kp) {
                const LAS unsigned char* vp = VT + (16 * mt + fr) * AT_VROW + 2 * (16 * (i4 + 2 * kp) + 4 * fq);
                const bf16x8 A = cat8(*(const LAS u32x2*)vp, *(const LAS u32x2*)(vp + 32));
                o = mfma16(A, bp[kp], o);
            }
            u32x2 w; w.x = pk2(o[0] * inv, o[1] * inv); w.y = pk2(o[2] * inv, o[3] * inv);
            *(u32x2*)(mix + tok * DM + h * 64 + 16 * mt + 4 * fq) = w;
        }
    }
}

#ifndef S2_PARTS
#define S2_PARTS 4
#endif
#ifndef TAB_SPLIT
#define TAB_SPLIT 15360
#endif
constexpr int S2_CW = 8 / S2_PARTS, S2_NBLK = 16 * S2_PARTS;
constexpr int S2_W = 0, S2_KD = 17408, S2_BUF = 17408 + 18432;
constexpr size_t WS_SB = WS_R3;
#define S2_GLOAD(rg_, n_) do { const unsigned char* ub_ = base + (size_t)(n_) * DN_UNIT_BYTES + (size_t)lt * 16; _Pragma("unroll") for (int i = 0; i < 8; ++i) \
        rg_[i] = *(const u32x4*)(ub_ + (i < 4 ? i * 4096 : 32768 + (i - 4) * 4096)); } while (0)
#define S2_LSTORE(rg_, buf_) do { _Pragma("unroll") for (int i = 0; i < 8; ++i) *(LAS u32x4*)(lds + (buf_) * S2_BUF + dst[i]) = rg_[i]; } while (0)
#define S2_ULOAD(u_, n_) do { const bf16_t* uT_ = (const bf16_t*)(base + (size_t)(n_) * DN_UNIT_BYTES + 57344) + (cbase + fr) * 64 + 4 * fq; \
        _Pragma("unroll") for (int m = 0; m < 4; ++m) u_[m] = *(const u32x2*)(uT_ + 16 * m); } while (0)
template <bool DO_ULOAD>
DI void scan2_step_compute(LAS unsigned char* lds, unsigned char* base, unsigned char* sbp, const float glv, int n,
                           const u32x2 (&uc)[4], u32x2 (&un)[4], f32x4 (&S)[8], bf16x8 (&BS)[4], int cbase, int fr, int fq, int lane) {
    const int buf = n & 1;
    if (DO_ULOAD) S2_ULOAD(un, n + 1);
    const LAS unsigned char* L = lds + buf * S2_BUF;
    const float gl = __int_as_float(__builtin_amdgcn_readlane(__float_as_int(glv), n));
    {
        unsigned char* p = sbp + (size_t)n * 32768 + lane * 16;
#pragma unroll
        for (int s = 0; s < 4; ++s) *(u32x4*)(p + s * 1024) = __builtin_bit_cast(u32x4, BS[s]);
    }
    const LAS unsigned char* Lw = L + S2_W + fr * 272 + 16 * fq;
    const LAS unsigned char* Lk = L + S2_KD + fr * 144 + 16 * fq;
#define RD_A(f_, Lx_, m_) do { _Pragma("unroll") for (int s_ = 0; s_ < 4; ++s_) { f_[s_] = *(const LAS bf16x8*)(Lx_ + (m_) * 16 * 272 + 64 * s_); f_[4 + s_] = *(const LAS bf16x8*)(Lx_ + ((m_) + 1) * 16 * 272 + 64 * s_); } } while (0)
#define MM_A(f_, X_, m_) do { _Pragma("unroll") for (int s_ = 0; s_ < 4; ++s_) { X_[m_] = mfma16(f_[s_], BS[s_], X_[m_]); X_[(m_) + 1] = mfma16(f_[4 + s_], BS[s_], X_[(m_) + 1]); } } while (0)
#define RD_KD(f_, t0_) do { _Pragma("unroll") for (int t_ = 0; t_ < 4; ++t_) { f_[2 * t_] = *(const LAS bf16x8*)(Lk + ((t0_) + t_) * 16 * 144); f_[2 * t_ + 1] = *(const LAS bf16x8*)(Lk + ((t0_) + t_) * 16 * 144 + 64); } } while (0)
#define MM_KD(f_, t0_) do { _Pragma("unroll") for (int t_ = 0; t_ < 4; ++t_) { S[(t0_) + t_] = mfma16(f_[2 * t_], BV[0], S[(t0_) + t_]); S[(t0_) + t_] = mfma16(f_[2 * t_ + 1], BV[1], S[(t0_) + t_]); } } while (0)
#define SB() __builtin_amdgcn_sched_barrier(0)
    f32x4 P[4];
#pragma unroll
    for (int m = 0; m < 4; ++m) P[m] = (f32x4){0.f, 0.f, 0.f, 0.f};
    bf16x8 fa[8], fb[8];
    RD_A(fa, Lw, 0); SB();
    RD_A(fb, Lw, 2); MM_A(fa, P, 0); SB();
    RD_KD(fa, 0);    MM_A(fb, P, 2); SB();
    f32x4 vn[4];
#pragma unroll
    for (int m = 0; m < 4; ++m) vn[m] = (f32x4){bflo(uc[m].x), bfhi(uc[m].x), bflo(uc[m].y), bfhi(uc[m].y)} - P[m];
    bf16x8 BV[2];
    BV[0] = pack8(vn[0], vn[1]); BV[1] = pack8(vn[2], vn[3]);
    {
        unsigned char* p = base + (size_t)n * DN_UNIT_BYTES + 57344 + (cbase >> 4) * 2048 + lane * 16;
        *(u32x4*)p = __builtin_bit_cast(u32x4, BV[0]); *(u32x4*)(p + 1024) = __builtin_bit_cast(u32x4, BV[1]);
    }
#pragma unroll
    for (int t = 0; t < 8; ++t) S[t] = S[t] * gl;
    RD_KD(fb, 4); MM_KD(fa, 0); SB();
    MM_KD(fb, 4);
#pragma unroll
    for (int s = 0; s < 4; ++s) BS[s] = pack8(S[2 * s], S[2 * s + 1]);
#undef RD_A
#undef MM_A
#undef RD_KD
#undef MM_KD
#undef SB
    __syncthreads();
}
template <bool DO_LSTORE, bool DO_GLOAD>
DI void scan2_step_load(LAS unsigned char* lds, const unsigned char* base, int n, const int (&dst)[8], u32x4 (&rr)[8], int lt) {
    const int buf = n & 1;
    if (DO_LSTORE) S2_LSTORE(rr, buf ^ 1);
    if (DO_GLOAD) S2_GLOAD(rr, n + 5);
    __syncthreads();
}
DI void scan2_unit(const Args& a, LAS unsigned char* lds, int sunit) {
    int tid = threadIdx.x;
    asm volatile("" : "+v"(tid));
    const int lane = tid & 63, wid = __builtin_amdgcn_readfirstlane(tid >> 6), fr = lane & 15, fq = lane >> 4;
    unsigned char* ws = a.ws;
    const int unit = sunit & 15, part = sunit >> 4, cbase = (128 / S2_PARTS) * part + 16 * (wid & (S2_CW - 1));
    unsigned char* base = ws + WS_R6 + (size_t)unit * 64 * DN_UNIT_BYTES;
    float glv = ((const float*)(ws + WS_GL))[unit * 64 + lane];
    asm volatile("v_mov_b32 %0, %0" : "+v"(glv));
    __syncthreads();
    if (wid < S2_CW) {
        unsigned char* sbp = ws + WS_SB + ((size_t)(unit * 64) * 8 + (cbase >> 4)) * 4096;
        f32x4 S[8]; bf16x8 BS[4]; u32x2 U0[4], U1[4];
#pragma unroll
        for (int t = 0; t < 8; ++t) S[t] = (f32x4){0.f, 0.f, 0.f, 0.f};
#pragma unroll
        for (int s = 0; s < 4; ++s) BS[s] = (bf16x8){0, 0, 0, 0, 0, 0, 0, 0};
        S2_ULOAD(U0, 0);
        __syncthreads();
#pragma unroll 1
        for (int n = 0; n < 62; n += 2) {
            scan2_step_compute<true>(lds, base, sbp, glv, n, U0, U1, S, BS, cbase, fr, fq, lane);
            scan2_step_compute<true>(lds, base, sbp, glv, n + 1, U1, U0, S, BS, cbase, fr, fq, lane);
        }
        scan2_step_compute<true>(lds, base, sbp, glv, 62, U0, U1, S, BS, cbase, fr, fq, lane);
        scan2_step_compute<false>(lds, base, sbp, glv, 63, U1, U0, S, BS, cbase, fr, fq, lane);
    } else if (wid < S2_CW + 4) {
        const int lt = tid - 64 * S2_CW;
        u32x4 R0[8], R1[8], R2[8], R3[8];
        int dst[8];
#pragma unroll
        for (int i = 0; i < 8; ++i) { const int g = lt + 256 * (i & 3); dst[i] = (i < 4) ? (S2_W + (g >> 4) * 272 + (g & 15) * 16) : (S2_KD + (g >> 3) * 144 + (g & 7) * 16); }
        S2_GLOAD(R0, 0); S2_GLOAD(R1, 1); S2_GLOAD(R2, 2); S2_GLOAD(R3, 3);
        S2_LSTORE(R0, 0);
        S2_GLOAD(R0, 4);
        __syncthreads();
#pragma unroll 1
        for (int n = 0; n < 56; n += 4) {
            scan2_step_load<true, true>(lds, base, n, dst, R1, lt);
            scan2_step_load<true, true>(lds, base, n + 1, dst, R2, lt);
            scan2_step_load<true, true>(lds, base, n + 2, dst, R3, lt);
            scan2_step_load<true, true>(lds, base, n + 3, dst, R0, lt);
        }
        scan2_step_load<true, true>(lds, base, 56, dst, R1, lt);
        scan2_step_load<true, true>(lds, base, 57, dst, R2, lt);
        scan2_step_load<true, true>(lds, base, 58, dst, R3, lt);
        scan2_step_load<true, false>(lds, base, 59, dst, R0, lt);
        scan2_step_load<true, false>(lds, base, 60, dst, R1, lt);
        scan2_step_load<true, false>(lds, base, 61, dst, R2, lt);
        scan2_step_load<true, false>(lds, base, 62, dst, R3, lt);
        scan2_step_load<false, false>(lds, base, 63, dst, R0, lt);
    } else {
        __syncthreads();
#pragma unroll 1
        for (int n = 0; n < 64; ++n) __syncthreads();
    }
}
#undef S2_GLOAD
#undef S2_LSTORE
#undef S2_ULOAD

constexpr int OP_QD = 0, OP_IN = 17408, OP_IMG = 17408 + 9216, OP_PART = 2 * OP_IMG, OP_RSTD = OP_PART + 2048, OP_TILE = OP_RSTD + 256;
DI void opass_load(const Args& a, int unit, u32x4 (&st)[3], bf16x8 (&bs)[4], bf16x8 (&bv)[2], u32x4 (&gg)[2]) {
    const int tid = opaque_tid(), lane = tid & 63, wid = tid >> 6;
    unsigned char* ws = a.ws;
    const int n = unit & 63, h = (unit >> 6) & 3, b = unit >> 8;
    const size_t tok0 = (size_t)b * SEQ + n * 64;
    const unsigned char* ub = ws + WS_R6 + (size_t)unit * DN_UNIT_BYTES;
    st[0] = *(const u32x4*)(ub + 16384 + tid * 16); st[1] = *(const u32x4*)(ub + 16384 + 8192 + tid * 16); st[2] = *(const u32x4*)(ub + 49152 + tid * 16);
    const unsigned char* sb = ws + WS_SB + ((size_t)unit * 8 + wid) * 4096 + lane * 16;
#pragma unroll
    for (int s = 0; s < 4; ++s) bs[s] = *(const bf16x8*)(sb + s * 1024);
    const unsigned char* vb = ub + 57344 + wid * 2048 + lane * 16;
    bv[0] = *(const bf16x8*)vb; bv[1] = *(const bf16x8*)(vb + 1024);
    const bf16_t* pg = (const bf16_t*)(ws + WS_R4) + (tok0 + (tid >> 3)) * 512 + h * 128 + 16 * (tid & 7);
    gg[0] = *(const u32x4*)pg; gg[1] = *(const u32x4*)(pg + 8);
}
DI void opass_stage(LAS unsigned char* img, const u32x4 (&st)[3]) {
    const int tid = opaque_tid();
    *(LAS u32x4*)(img + OP_QD + (tid >> 4) * 272 + (tid & 15) * 16) = st[0];
    *(LAS u32x4*)(img + OP_QD + (32 + (tid >> 4)) * 272 + (tid & 15) * 16) = st[1];
    *(LAS u32x4*)(img + OP_IN + (tid >> 3) * 144 + (tid & 7) * 16) = st[2];
}
DI void opass_compute(const Args& a, LAS unsigned char* lds, const LAS unsigned char* img, int unit, const bf16x8 (&BS)[4], const bf16x8 (&BV)[2], const u32x4 (&gg)[2]) {
    const int tid = opaque_tid(), lane = tid & 63, wid = tid >> 6, fr = lane & 15, fq = lane >> 4;
    unsigned char* ws = a.ws;
    const int n = unit & 63, h = (unit >> 6) & 3, b = unit >> 8;
    const size_t tok0 = (size_t)b * SEQ + n * 64;
    f32x4 Q[4];
    {
        bf16x8 aq[4][4], ai[4][2];
#pragma unroll
        for (int m = 0; m < 4; ++m) {
#pragma unroll
            for (int s = 0; s < 4; ++s) aq[m][s] = *(const LAS bf16x8*)(img + OP_QD + (16 * m + fr) * 272 + 64 * s + 16 * fq);
#pragma unroll
            for (int s = 0; s < 2; ++s) ai[m][s] = *(const LAS bf16x8*)(img + OP_IN + (16 * m + fr) * 144 + 64 * s + 16 * fq);
        }
#pragma unroll
        for (int m = 0; m < 4; ++m) {
            f32x4 q = {0.f, 0.f, 0.f, 0.f};
#pragma unroll
            for (int s = 0; s < 4; ++s) q = mfma16(aq[m][s], BS[s], q);
#pragma unroll
            for (int s = 0; s < 2; ++s) q = mfma16(ai[m][s], BV[s], q);
            Q[m] = q;
        }
    }
    LAS float* part = (LAS float*)(lds + OP_PART);
    LAS float* rstd = (LAS float*)(lds + OP_RSTD);
    LAS unsigned char* tile = lds + OP_TILE;
#pragma unroll
    for (int m = 0; m < 4; ++m)
#pragma unroll
        for (int r = 0; r < 4; ++r) {
            float v = Q[m][r] * Q[m][r];
            v += dppf<0xB1>(v); v += dppf<0x4E>(v); v += dppf<0x141>(v); v += dppf<0x140>(v);
            if (fr == 0) part[wid * 64 + 16 * m + 4 * fq + r] = v;
        }
    __syncthreads();
    if (tid < 64) {
        float sum = 0.f;
#pragma unroll
        for (int w = 0; w < 8; ++w) sum += part[w * 64 + tid];
        rstd[tid] = rsqrtf(sum * (1.0f / 128.0f) + EPS);
    }
    __syncthreads();
    {
        const float nwc = a.in[I_DNNORM][16 * wid + fr];
#pragma unroll
        for (int m = 0; m < 4; ++m) {
            const f32x4 rs4 = *(const LAS f32x4*)(rstd + 16 * m + 4 * fq);
#pragma unroll
            for (int r = 0; r < 4; ++r) *(LAS bf16_t*)(tile + (16 * m + 4 * fq + r) * 272 + 2 * (16 * wid + fr)) = (bf16_t)f2bf(Q[m][r] * rs4[r] * nwc);
        }
    }
    __syncthreads();
    {
        const int token = tid >> 3, g8 = tid & 7;
        const u32x4 y0 = *(const LAS u32x4*)(tile + token * 272 + g8 * 32), y1 = *(const LAS u32x4*)(tile + token * 272 + g8 * 32 + 16);
        const unsigned yw[8] = {y0.x, y0.y, y0.z, y0.w, y1.x, y1.y, y1.z, y1.w}, gw[8] = {gg[0].x, gg[0].y, gg[0].z, gg[0].w, gg[1].x, gg[1].y, gg[1].z, gg[1].w};
        unsigned ow[8];
#pragma unroll
        for (int e = 0; e < 8; ++e) ow[e] = pk2(bflo(yw[e]) * siluf_(bflo(gw[e])), bfhi(yw[e]) * siluf_(bfhi(gw[e])));
        bf16_t* mp = (bf16_t*)(ws + WS_R1) + (tok0 + token) * DM + 512 + h * 128 + 16 * g8;
        *(u32x4*)mp = (u32x4){ow[0], ow[1], ow[2], ow[3]}; *(u32x4*)(mp + 8) = (u32x4){ow[4], ow[5], ow[6], ow[7]};
    }
}
DI void phase_opass(const Args& a, LAS unsigned char* lds, int bid, int G) {
    u32x4 stA[3], stB[3], ggA[2], ggB[2]; bf16x8 bsA[4], bsB[4], bvA[2], bvB[2];
    int u = bid, buf = 0;
    if (u < 1024) opass_load(a, u, stA, bsA, bvA, ggA);
    while (u < 1024) {
        opass_stage(lds + buf * OP_IMG, stA);
        __syncthreads();
        const int un = u + G;
        if (un < 1024) opass_load(a, un, stB, bsB, bvB, ggB);
        opass_compute(a, lds, lds + buf * OP_IMG, u, bsA, bvA, ggA);
#pragma unroll
        for (int i = 0; i < 3; ++i) stA[i] = stB[i];
#pragma unroll
        for (int i = 0; i < 4; ++i) bsA[i] = bsB[i];
        bvA[0] = bvB[0]; bvA[1] = bvB[1]; ggA[0] = ggB[0]; ggA[1] = ggB[1];
        buf ^= 1; u = un;
    }
}

DI void phase_tables(const Args& a, int row_lo, int row_hi, int vb, int nvb) {
    const int tid = opaque_tid(), lane = tid & 63, wid = tid >> 6;
    unsigned char* ws = a.ws;
    unsigned char* dn8 = ws + WS_DNT;
    unsigned char* up8 = ws + WS_UPT;
    const float* n2 = a.in[I_N2W];
    f32x4 nw[4];
#pragma unroll
    for (int q = 0; q < 4; ++q) nw[q] = *(const f32x4*)(n2 + 16 * lane + 4 * q) * PEER_SC_D;
    for (int e0 = row_lo + vb * 8 + wid; e0 < row_hi; e0 += 2 * nvb * 8) {
        f32x4 v[2][2][4];
#pragma unroll
        for (int k = 0; k < 2; ++k) {
            const int e = e0 + k * nvb * 8, ec = e < row_hi ? e : e0;
#pragma unroll
            for (int q = 0; q < 4; ++q) { v[k][0][q] = __builtin_nontemporal_load((const f32x4*)(a.in[I_EDOWN] + (size_t)ec * DM + 16 * lane) + q); v[k][1][q] = __builtin_nontemporal_load((const f32x4*)(a.in[I_EUP] + (size_t)ec * DM + 16 * lane) + q); }
        }
#pragma unroll
        for (int k = 0; k < 2; ++k) {
            const int e = e0 + k * nvb * 8;
#pragma unroll
            for (int which = 0; which < 2; ++which) {
                u32x4 o;
#pragma unroll
                for (int q = 0; q < 4; ++q) {
                    const f32x4 x = which ? v[k][1][q] * PEER_SC_U : v[k][0][q] * nw[q];
                    unsigned p = __builtin_amdgcn_cvt_pk_fp8_f32(x[0], x[1], 0, false);
                    p = __builtin_amdgcn_cvt_pk_fp8_f32(x[2], x[3], p, true);
                    o[q] = p;
                }
                if (e < row_hi) *(u32x4*)((which ? up8 : dn8) + (size_t)(lane >> 3) * PEER_SLICE + (size_t)e * 128 + (lane & 7) * 16) = o;
            }
        }
    }
}

DI void ce(float& hi, float& lo) { const float a = hi, b = lo; hi = fmaxf(a, b); lo = fminf(a, b); }
DI void sort16_desc(float (&x)[16]) {
    ce(x[0], x[13]); ce(x[1], x[12]); ce(x[2], x[15]); ce(x[3], x[14]); ce(x[4], x[8]); ce(x[5], x[6]); ce(x[7], x[11]); ce(x[9], x[10]);
    ce(x[0], x[5]); ce(x[1], x[7]); ce(x[2], x[9]); ce(x[3], x[4]); ce(x[6], x[13]); ce(x[8], x[14]); ce(x[10], x[15]); ce(x[11], x[12]);
    ce(x[0], x[1]); ce(x[2], x[3]); ce(x[4], x[5]); ce(x[6], x[8]); ce(x[7], x[9]); ce(x[10], x[11]); ce(x[12], x[13]); ce(x[14], x[15]);
    ce(x[0], x[2]); ce(x[1], x[3]); ce(x[4], x[10]); ce(x[5], x[11]); ce(x[6], x[7]); ce(x[8], x[9]); ce(x[12], x[14]); ce(x[13], x[15]);
    ce(x[1], x[2]); ce(x[3], x[12]); ce(x[4], x[6]); ce(x[5], x[7]); ce(x[8], x[10]); ce(x[9], x[11]); ce(x[13], x[14]);
    ce(x[1], x[4]); ce(x[2], x[6]); ce(x[5], x[8]); ce(x[7], x[10]); ce(x[9], x[13]); ce(x[11], x[14]);
    ce(x[2], x[4]); ce(x[3], x[6]); ce(x[9], x[12]); ce(x[11], x[13]);
    ce(x[3], x[5]); ce(x[6], x[8]); ce(x[7], x[9]); ce(x[10], x[12]);
    ce(x[3], x[4]); ce(x[5], x[6]); ce(x[7], x[8]); ce(x[9], x[10]); ce(x[11], x[12]);
    ce(x[6], x[7]); ce(x[8], x[9]);
}
DI void bmerge16_desc(float (&x)[16]) {
#pragma unroll
    for (int j = 8; j > 0; j >>= 1)
#pragma unroll
        for (int i = 0; i < 16; ++i) { const int l = i ^ j; if (l > i) ce(x[i], x[l]); }
}
DI void merge_top16(float (&x)[16], const float (&y)[16]) {
#pragma unroll
    for (int i = 0; i < 16; ++i) x[i] = fmaxf(x[i], y[15 - i]);
    bmerge16_desc(x);
}
struct CandTab { int i[64]; int j[64]; };
constexpr CandTab make_cand() {
    CandTab t{}; int n = 0;
    for (int i = 0; i < 16; ++i) for (int j = 0; j < 16; ++j) if ((i + 1) * (j + 1) <= 16) { t.i[n] = i; t.j[n] = j; ++n; }
    for (; n < 64; ++n) { t.i[n] = -1; t.j[n] = -1; }
    return t;
}
constexpr CandTab CAND = make_cand();

DI void topk_half(const bf16_t* qrow  , const LAS unsigned char* keys  , int r32, int hh, float (&top)[16]) {
    bf16x8 bq[8];
#pragma unroll
    for (int s = 0; s < 8; ++s) bq[s] = *(const bf16x8*)(qrow + 16 * s + 8 * hh);
    float run[16];
#pragma unroll
    for (int mt = 0; mt < 4; ++mt) {
        f32x16 acc;
#pragma unroll
        for (int e = 0; e < 16; ++e) acc[e] = 0.f;
#pragma unroll
        for (int s = 0; s < 8; ++s) { const bf16x8 A = *(const LAS bf16x8*)(keys + (32 * mt + r32) * 272 + 32 * s + 16 * hh); acc = mfma32(A, bq[s], acc); }
        asm volatile("" ::: "memory");
        float cur[16];
#pragma unroll
        for (int e = 0; e < 16; ++e) {
            const unsigned key = 32 * mt + (e & 3) + 8 * (e >> 2) + 4 * hh;
            cur[e] = __uint_as_float((__float_as_uint(acc[e]) & ~127u) | key);
        }
        sort16_desc(cur);
        if (mt == 0) {
#pragma unroll
            for (int e = 0; e < 16; ++e) run[e] = cur[e];
        } else merge_top16(run, cur);
        asm volatile("" : "+v"(run[0]), "+v"(run[1]), "+v"(run[2]), "+v"(run[3]), "+v"(run[4]), "+v"(run[5]), "+v"(run[6]), "+v"(run[7]));
        asm volatile("" : "+v"(run[8]), "+v"(run[9]), "+v"(run[10]), "+v"(run[11]), "+v"(run[12]), "+v"(run[13]), "+v"(run[14]), "+v"(run[15]));
    }
    float oth[16];
#pragma unroll
    for (int e = 0; e < 16; ++e) oth[e] = __shfl_xor(run[e], 32);
    merge_top16(run, oth);
#pragma unroll
    for (int e = 0; e < 16; ++e) top[e] = run[e];
}

DI void phase_topk(const Args& a, LAS unsigned char* lds, int bid, int G) {
    const int wid = threadIdx.x >> 6;
    unsigned char* ws = a.ws;
    const bf16_t* qry = (const bf16_t*)(ws + WS_QRY);
    const bf16_t* keys = (const bf16_t*)(ws + WS_KEYS);
    const float* rstd2 = (const float*)(ws + WS_RSTD2);
    int* idx_out = (int*)(ws + WS_IDX);
    float* gate_out = (float*)(ws + WS_GATES);
    LAS unsigned* lw = (LAS unsigned*)(lds + 2 * 128 * 272 + wid * 8192);
    __syncthreads();
    for (int c = threadIdx.x; c < 2 * 128 * 16; c += NTHR) {
        const int row = c >> 4, ch = c & 15;
        *(LAS u32x4*)(lds + row * 272 + ch * 16) = *(const u32x4*)(keys + row * 128 + ch * 8);
    }
    __syncthreads();
    const bool local_map = (G == 256);
    for (int it_ = 0; it_ < (local_map ? 2 : (512 * 8 - 1 - (bid * 8 + wid)) / (G * 8) + 1); ++it_) {
        const int item = local_map ? ((2 * bid + it_) * 8 + wid) : (bid * 8 + wid + it_ * G * 8);
        if (item >= 512 * 8) break;
        int lane = threadIdx.x & 63;
        asm volatile("" : "+v"(lane));
        const int r32 = lane & 31, hh = lane >> 5;
        const int tg = item >> 3, h = item & 7, tok = tg * 32 + r32;
        float v1[16], v2[16];
        topk_half(qry + (size_t)tok * 2048 + h * 256, lds, r32, hh, v1);
        topk_half(qry + (size_t)tok * 2048 + h * 256 + 128, lds + 128 * 272, r32, hh, v2);
#pragma unroll
        for (int m = 0; m < 16; ++m) { lw[m * 64 + lane] = __float_as_uint(v1[m]); lw[(16 + m) * 64 + lane] = __float_as_uint(v2[m]); }
        float ca[16], cb[16];
#pragma unroll
        for (int m = 0; m < 32; ++m) {
            constexpr float NEG = -3.0e38f;
            float s0 = NEG, s1 = NEG;
            const int i0 = CAND.i[m], j0 = CAND.j[m], i1 = CAND.i[32 + m], j1 = CAND.j[32 + m];
            if (i0 >= 0) s0 = __uint_as_float((__float_as_uint(v1[i0 >= 0 ? i0 : 0] + v2[j0 >= 0 ? j0 : 0]) & ~255u) | (unsigned)(i0 * 16 + j0));
            if (i1 >= 0) s1 = __uint_as_float((__float_as_uint(v1[i1 >= 0 ? i1 : 0] + v2[j1 >= 0 ? j1 : 0]) & ~255u) | (unsigned)(i1 * 16 + j1));
            const float s = hh ? s1 : s0;
            if (m < 16) ca[m] = s; else cb[m - 16] = s;
        }
        sort16_desc(ca); sort16_desc(cb); merge_top16(ca, cb);
#pragma unroll
        for (int e = 0; e < 16; ++e) cb[e] = __shfl_xor(ca[e], 32);
        merge_top16(ca, cb);
        const float rs = rsqrtf(rstd2[tok] * (1.0f / DM) + EPS);
        float ex[16], sum = 0.f;
#pragma unroll
        for (int e = 0; e < 16; ++e) { ex[e] = __expf((ca[e] - ca[0]) * rs); sum += ex[e]; }
        const float inv = 1.0f / sum;
        int idx[16];
#pragma unroll
        for (int e = 0; e < 16; ++e) {
            const unsigned code = __float_as_uint(ca[e]) & 255u;
            const unsigned i1 = lw[(code >> 4) * 64 + lane] & 127u, i2 = lw[(16 + (code & 15)) * 64 + lane] & 127u;
            idx[e] = (int)(i1 * 128 + i2);
        }
        if (hh == 0) {
#pragma unroll
            for (int k = 0; k < 4; ++k) *(i32x4*)(idx_out + (size_t)tok * 128 + h * 16 + 4 * k) = (i32x4){idx[4 * k], idx[4 * k + 1], idx[4 * k + 2], idx[4 * k + 3]};
        } else {
#pragma unroll
            for (int k = 0; k < 4; ++k) *(f32x4*)(gate_out + (size_t)tok * 128 + h * 16 + 4 * k) = (f32x4){ex[4 * k] * inv, ex[4 * k + 1] * inv, ex[4 * k + 2] * inv, ex[4 * k + 3] * inv};
        }
    }
}

constexpr int PG_IROW = 264;
constexpr int PG_WROW = 528;
constexpr int PG_WOFF = 64 * PG_IROW;
DI f32x2 cvt2(unsigned w, bool hi) { return hi ? __builtin_amdgcn_cvt_pk_f32_fp8(w, true) : __builtin_amdgcn_cvt_pk_f32_fp8(w, false); }
DI float dot16_fp8(const f32x2 (&h)[8], const u32x4 v) {
    f32x2 acc = h[0] * cvt2(v.x, false);
    acc += h[1] * cvt2(v.x, true);
    acc += h[2] * cvt2(v.y, false);
    acc += h[3] * cvt2(v.y, true);
    acc += h[4] * cvt2(v.z, false);
    acc += h[5] * cvt2(v.z, true);
    acc += h[6] * cvt2(v.w, false);
    acc += h[7] * cvt2(v.w, true);
    return acc[0] + acc[1];
}
DI void axpy16_fp8(f32x2 (&acc)[8], const float w, const u32x4 v) {
    const f32x2 w2 = {w, w};
    acc[0] += w2 * cvt2(v.x, false); acc[1] += w2 * cvt2(v.x, true);
    acc[2] += w2 * cvt2(v.y, false); acc[3] += w2 * cvt2(v.y, true);
    acc[4] += w2 * cvt2(v.z, false); acc[5] += w2 * cvt2(v.z, true);
    acc[6] += w2 * cvt2(v.w, false); acc[7] += w2 * cvt2(v.w, true);
}
template <int CTRL> DI float dpp_f(float v) { return __int_as_float(__builtin_amdgcn_update_dpp(0, __float_as_int(v), CTRL, 0xf, 0xf, true)); }
DI float sum8(float v) {
    v += dpp_f<0xB1>(v);
    v += dpp_f<0x4E>(v);
    v += dpp_f<0x141>(v);
    return v;
}
#define PG_LOAD8(dst, base, iw) do { _Pragma("unroll") for (int m_ = 0; m_ < 8; ++m_) { \
        const unsigned e_ = ((m_ & 1) ? ((iw)[m_ >> 1] >> 16) : ((iw)[m_ >> 1] & 0xffffu)); \
        dst[m_] = __builtin_amdgcn_raw_buffer_load_b128(base, e_ * 128u + joff, soff, 0); } } while (0)
DI void phase_gather(const Args& a, LAS unsigned char* lds, int bid, int G) {
    const int wid = threadIdx.x >> 6;
    unsigned char* ws = a.ws;
    const bf16_t* h2b = (const bf16_t*)(ws + WS_H2B);
    const __amdgpu_buffer_rsrc_t rs_dn = __builtin_amdgcn_make_buffer_rsrc((void*)(ws + WS_DNT), 0, 8 * (int)PEER_SLICE, 0x00020000);
    const __amdgpu_buffer_rsrc_t rs_up = __builtin_amdgcn_make_buffer_rsrc((void*)(ws + WS_UPT), 0, 8 * (int)PEER_SLICE, 0x00020000);
    const int* idxp = (const int*)(ws + WS_IDX);
    const float* gatep = (const float*)(ws + WS_GATES);
    const float* rstd2 = (const float*)(ws + WS_RSTD2);
    for (int tile = bid; tile < 256; tile += G) {
        int lane = threadIdx.x & 63;
        asm volatile("" : "+v"(lane));
        const int g = lane >> 3, j = lane & 7, tl = wid * 8 + g, tok = tile * 64 + tl;
        __syncthreads();
        for (int e = threadIdx.x; e < 2048; e += NTHR) {
            const i32x4 v = *(const i32x4*)(idxp + (size_t)tile * 8192 + 4 * e);
            u32x2 w; w.x = (unsigned)v[0] | ((unsigned)v[1] << 16); w.y = (unsigned)v[2] | ((unsigned)v[3] << 16);
            *(LAS u32x2*)(lds + (e >> 5) * PG_IROW + (e & 31) * 8) = w;
        }
        __syncthreads();
        const LAS unsigned char* irow = lds + tl * PG_IROW;
        LAS unsigned char* wrow = lds + PG_WOFF + tl * PG_WROW;
#ifndef GD_REPS
#define GD_REPS 1
#endif
#pragma unroll 1
        for (int hp_ = 0; hp_ < 2 * GD_REPS; ++hp_) { const int hp = hp_ & 1;
            float p[64];
#pragma unroll
            for (int k = 0; k < 64; ++k) p[k] = 0.f;
            const LAS unsigned char* ir = irow + hp * 128;
#pragma unroll 1
            for (int c = 0; c < 8; ++c) {
                f32x2 hf[8];
                {
                    const u32x4* hp_ = (const u32x4*)(h2b + (size_t)tok * DM + 128 * c + 16 * j);
                    const u32x4 h0 = hp_[0], h1 = hp_[1];
                    hf[0] = (f32x2){bflo(h0.x), bfhi(h0.x)}; hf[1] = (f32x2){bflo(h0.y), bfhi(h0.y)}; hf[2] = (f32x2){bflo(h0.z), bfhi(h0.z)}; hf[3] = (f32x2){bflo(h0.w), bfhi(h0.w)};
                    hf[4] = (f32x2){bflo(h1.x), bfhi(h1.x)}; hf[5] = (f32x2){bflo(h1.y), bfhi(h1.y)}; hf[6] = (f32x2){bflo(h1.z), bfhi(h1.z)}; hf[7] = (f32x2){bflo(h1.w), bfhi(h1.w)};
                }
                const __amdgpu_buffer_rsrc_t sb = rs_dn; const unsigned joff = j * 16; const int soff = c * (int)PEER_SLICE;
                u32x4 va[8], vb[8];
                { const u32x4 iw = *(const LAS u32x4*)(ir); PG_LOAD8(va, sb, iw); }
#pragma unroll
                for (int bt = 0; bt < 8; bt += 2) {
                    { const u32x4 iw = *(const LAS u32x4*)(ir + (bt + 1) * 16); PG_LOAD8(vb, sb, iw); }
#pragma unroll
                    for (int m = 0; m < 8; ++m) p[8 * bt + m] += dot16_fp8(hf, va[m]);
                    if (bt + 2 < 8) { const u32x4 iw = *(const LAS u32x4*)(ir + (bt + 2) * 16); PG_LOAD8(va, sb, iw); }
#pragma unroll
                    for (int m = 0; m < 8; ++m) p[8 * (bt + 1) + m] += dot16_fp8(hf, vb[m]);
                }
            }
            const float rs = rsqrtf(rstd2[tok] * (1.0f / DM) + EPS) * (1.0f / PEER_SC_D);
#pragma unroll
            for (int bt = 0; bt < 8; ++bt) {
                float mine = 0.f;
#pragma unroll
                for (int m = 0; m < 8; ++m) { const float s_ = sum8(p[8 * bt + m]); mine = (j == m) ? s_ : mine; }
                const float x = mine * rs;
                const float gt = gatep[(size_t)tok * 128 + 64 * hp + 8 * bt + j];
                const float w = gt * 0.5f * x * (1.0f + erff(x * 0.70710678118654752f)) * (1.0f / PEER_SC_U);
                *(LAS float*)(wrow + (64 * hp + 8 * bt + j) * 4) = w;
            }
        }
        int lane2 = threadIdx.x & 63;
        asm volatile("" : "+v"(lane2));
        const int g2 = lane2 >> 3, j2 = lane2 & 7, tl2 = wid * 8 + g2, tok2 = tile * 64 + tl2;
        const LAS unsigned char* irow2 = lds + tl2 * PG_IROW;
        const LAS unsigned char* wrow2 = lds + PG_WOFF + tl2 * PG_WROW;
#pragma unroll 1
        for (int c = 0; c < 8; ++c) {
            f32x2 acc[8];
#pragma unroll
            for (int i = 0; i < 8; ++i) acc[i] = (f32x2){0.f, 0.f};
            const __amdgpu_buffer_rsrc_t sb = rs_up; const unsigned joff = j2 * 16; const int soff = c * (int)PEER_SLICE;
            u32x4 va[8], vb[8];
            { const u32x4 iw = *(const LAS u32x4*)(irow2); PG_LOAD8(va, sb, iw); }
#pragma unroll 1
            for (int bt = 0; bt < 16; bt += 2) {
                { const u32x4 iw = *(const LAS u32x4*)(irow2 + (bt + 1) * 16); PG_LOAD8(vb, sb, iw); }
                { const f32x4 w0 = *(const LAS f32x4*)(wrow2 + bt * 32), w1 = *(const LAS f32x4*)(wrow2 + bt * 32 + 16);
#pragma unroll
                  for (int m = 0; m < 4; ++m) { axpy16_fp8(acc, w0[m], va[m]); }
#pragma unroll
                  for (int m = 0; m < 4; ++m) { axpy16_fp8(acc, w1[m], va[4 + m]); } }
                if (bt + 2 < 16) { const u32x4 iw = *(const LAS u32x4*)(irow2 + (bt + 2) * 16); PG_LOAD8(va, sb, iw); }
                { const f32x4 w0 = *(const LAS f32x4*)(wrow2 + (bt + 1) * 32), w1 = *(const LAS f32x4*)(wrow2 + (bt + 1) * 32 + 16);
#pragma unroll
                  for (int m = 0; m < 4; ++m) { axpy16_fp8(acc, w0[m], vb[m]); }
#pragma unroll
                  for (int m = 0; m < 4; ++m) { axpy16_fp8(acc, w1[m], vb[4 + m]); } }
            }
            const u32x4* xp = (const u32x4*)(h2b + (size_t)tok2 * DM + 128 * c + 16 * j2);
            const u32x4 x0 = xp[0], x1v = xp[1];
            f32x4* op = (f32x4*)(a.out + (size_t)tok2 * DM + 128 * c + 16 * j2);
            op[0] = (f32x4){bflo(x0.x) + acc[0][0], bfhi(x0.x) + acc[0][1], bflo(x0.y) + acc[1][0], bfhi(x0.y) + acc[1][1]};
            op[1] = (f32x4){bflo(x0.z) + acc[2][0], bfhi(x0.z) + acc[2][1], bflo(x0.w) + acc[3][0], bfhi(x0.w) + acc[3][1]};
            op[2] = (f32x4){bflo(x1v.x) + acc[4][0], bfhi(x1v.x) + acc[4][1], bflo(x1v.y) + acc[5][0], bfhi(x1v.y) + acc[5][1]};
            op[3] = (f32x4){bflo(x1v.z) + acc[6][0], bfhi(x1v.z) + acc[6][1], bflo(x1v.w) + acc[7][0], bfhi(x1v.w) + acc[7][1]};
        }
    }
}

constexpr int N_PHASES = 9;
__global__ void __launch_bounds__(NTHR, 2) fwd(Args a) {
    extern __shared__ __attribute__((aligned(16))) unsigned char lds_raw[];
    LAS unsigned char* lds = (LAS unsigned char*)lds_raw;
    const int bid = blockIdx.x, G = gridDim.x;
    unsigned char* ws = a.ws;
    const int lo = a.ph_lo, hi = a.ph_hi;
    XcdBarrier xb;
    if (hi - lo > 1) {
        LAS unsigned* st = (LAS unsigned*)(lds + LDS_BYTES - 16);
        if (threadIdx.x == 0) { st[0] = 0u; st[1] = 0u; }
        __syncthreads();
        xb = xcd_barrier_post((unsigned*)(ws + WS_BAR), (volatile LAS unsigned*)st);
    }
#ifdef ONLY_PHASE
#define IN(k) ((k) == ONLY_PHASE)
#else
#define IN(k) (lo <= (k) && (k) < hi)
#endif
#define SEAM(k) do { if (IN(k) && IN((k) + 1)) xcd_barrier(xb); } while (0)
#ifndef REPEAT_MASK
#define REPEAT_MASK 0
#endif
#define REPS(k) (((REPEAT_MASK >> (k)) & 1) ? 2 : 1)
    for (int rep = 0; rep < REPS(0); ++rep) { if (IN(0)) { phase_prep(a, lds, bid, G);
#ifdef P0_TWICE
        __syncthreads(); phase_prep(a, lds, bid, G);
#endif
    }
    SEAM(0); }
    for (int rep = 0; rep < REPS(1); ++rep) { if (IN(1)) { pg8::EpiProj e{(bf16_t*)(ws + WS_R2), (bf16_t*)(ws + WS_R3), (bf16_t*)(ws + WS_R4), (const float*)(ws + WS_RSTD1)};
                 pg8::StaticOrder so; so.init(NTOK, NPROJ, G, bid);
                 pg8::gemm_phase<pg8::EpiProj, pg8::StaticOrder, true, true>(lds, pg8::Gemm{(const bf16_t*)(ws + WS_R1), (const bf16_t*)(ws + WS_WINT), NTOK, NPROJ, DM}, so, e); }
    SEAM(1); }
    for (int rep = 0; rep < REPS(2); ++rep) { if (IN(2)) {
#ifndef QK_REPS
#define QK_REPS 1
#endif
#ifndef DP_REPS
#define DP_REPS 1
#endif
        for (int rr = 0; rr < QK_REPS; ++rr) phase_qknorm(a, bid, G);
        for (int rr = 0; rr < DP_REPS; ++rr) phase_dnprep(a, lds, bid, G); }
    SEAM(2); }
    for (int rep = 0; rep < REPS(3); ++rep) { if (IN(3)) {
#ifndef SCAN_REPS
#define SCAN_REPS 1
#endif
#ifndef ATTN_REPS
#define ATTN_REPS 1
#endif
        if (G >= 128) {
            for (int rr = 0; rr < SCAN_REPS; ++rr) if (bid < S2_NBLK) { const int k = bid >> 3; scan2_unit(a, lds, (k % S2_PARTS) * 16 + (bid & 7) + 8 * (k / S2_PARTS)); }
            for (int rr = 0; rr < ATTN_REPS; ++rr) if (bid >= S2_NBLK) { for (int u = bid - S2_NBLK; u < 512; u += G - S2_NBLK) attn_unit(a, lds, u); }
            if (bid >= S2_NBLK) phase_tables(a, 0, TAB_SPLIT, bid - S2_NBLK, G - S2_NBLK);
            else if (TAB_SPLIT < 16384) phase_tables(a, TAB_SPLIT, 16384, bid, S2_NBLK);
        } else {
            for (int u = bid; u < S2_NBLK; u += G) scan2_unit(a, lds, u);
            for (int u = bid; u < 512; u += G) attn_unit(a, lds, u);
            phase_tables(a, 0, 16384, bid, G);
        }
    }
    SEAM(3); }
    for (int rep = 0; rep < REPS(4); ++rep) { if (IN(4)) {
        phase_opass(a, lds, bid, G);
    }
    SEAM(4); }
    for (int rep = 0; rep < REPS(5); ++rep) { if (IN(5)) { pg8::EpiOut e{a.in[I_X], a.out, (bf16_t*)(ws + WS_H2B), (float*)(ws + WS_RSTD2)};
                 pg8::StaticOrder so; so.init(NTOK, DM, G, bid);
                 pg8::gemm_phase<pg8::EpiOut, pg8::StaticOrder, true, true>(lds, pg8::Gemm{(const bf16_t*)(ws + WS_R1), (const bf16_t*)(ws + WS_WOUTT), NTOK, DM, DM}, so, e); }
    SEAM(5); }
    for (int rep = 0; rep < REPS(6); ++rep) { if (IN(6)) {
                 __syncthreads();
                 pg8::EpiQry e{(bf16_t*)(ws + WS_QRY)};
                 pg8::StaticOrder so; so.init(NTOK, 2048, G, bid);
                 pg8::gemm_phase<pg8::EpiQry, pg8::StaticOrder, true, true>(lds, pg8::Gemm{(const bf16_t*)(ws + WS_H2B), (const bf16_t*)(ws + WS_WQT), NTOK, 2048, DM}, so, e); }
    SEAM(6); }
    for (int rep = 0; rep < REPS(7); ++rep) { if (IN(7)) phase_topk(a, lds, bid, G);
    if (G == 256 && IN(7) && IN(8)) { asm volatile("s_waitcnt vmcnt(0)" ::: "memory"); __syncthreads(); }
    else SEAM(7); }
    if (IN(8)) phase_gather(a, lds, bid, G);
}

extern "C" void kernel_launch(void* const* d_in, const int* in_sizes, int n_in, void* d_out, int out_size, void* d_ws, size_t ws_size, hipStream_t stream) {
    static int grid = 0;
    if (grid == 0) {
        if (n_in != 17 || out_size != NTOK * DM || ws_size < WS_END) { fprintf(stderr, "kernel_launch: unexpected shapes (n_in %d out %d ws %zu)\n", n_in, out_size, ws_size); grid = -1; return; }
        int dev = 0, cus = 0, per_cu = 0;
        if (hipGetDevice(&dev) != hipSuccess || hipDeviceGetAttribute(&cus, hipDeviceAttributeMultiprocessorCount, dev) != hipSuccess) { grid = -1; return; }
        if (hipFuncSetAttribute((const void*)fwd, hipFuncAttributeMaxDynamicSharedMemorySize, LDS_BYTES) != hipSuccess) { fprintf(stderr, "kernel_launch: hipFuncSetAttribute failed\n"); grid = -1; return; }
        if (hipOccupancyMaxActiveBlocksPerMultiprocessor(&per_cu, (const void*)fwd, NTHR, LDS_BYTES) != hipSuccess || per_cu < 1) { fprintf(stderr, "kernel_launch: occupancy query says %d\n", per_cu); }
        (void)hipGetLastError();
        grid = cus;
    }
    if (grid < 0) return;
    Args a{};
    for (int i = 0; i < 17; ++i) a.in[i] = (const float*)d_in[i];
    a.out = (float*)d_out; a.ws = (unsigned char*)d_ws;
#if N_LAUNCH_PER_PHASE
    for (int p = 0; p < N_PHASES; ++p) { a.ph_lo = p; a.ph_hi = p + 1; hipLaunchKernelGGL(fwd, dim3(grid), dim3(NTHR), LDS_BYTES, stream, a); }
#else
    (void)hipMemsetAsync((unsigned char*)d_ws + WS_BAR, 0, XCD_BAR_WORDS * 4, stream);
    a.ph_lo = 0; a.ph_hi = N_PHASES;
    hipLaunchKernelGGL(fwd, dim3(grid), dim3(NTHR), LDS_BYTES, stream, a);
#endif
}
```

```cpp
#include <hip/hip_runtime.h>
#include <stdint.h>
#include <stdio.h>

#ifndef N_LAUNCH_PER_PHASE
#define N_LAUNCH_PER_PHASE 0
#endif

#define DI __device__ __forceinline__
#define LAS __attribute__((address_space(3)))
typedef unsigned short bf16_t;
typedef short bf16x8 __attribute__((ext_vector_type(8)));
typedef short bf16x4 __attribute__((ext_vector_type(4)));
typedef float f32x2 __attribute__((ext_vector_type(2)));
typedef float f32x4 __attribute__((ext_vector_type(4)));
typedef float f32x16 __attribute__((ext_vector_type(16)));
typedef unsigned u32x2 __attribute__((ext_vector_type(2)));
typedef unsigned u32x4 __attribute__((ext_vector_type(4)));
typedef int i32x4 __attribute__((ext_vector_type(4)));

constexpr int NTOK = 16384, DM = 1024, SEQ = 4096;
constexpr int INW = 2824, NPROJ = 2816;
constexpr int NTHR = 512;
constexpr float EPS = 1e-6f;

constexpr size_t MiB = 1u << 20;
constexpr size_t WS_BAR = 0;
constexpr size_t WS_KEYS = 128 * 1024;
constexpr size_t WS_ROPE = 256 * 1024;
constexpr size_t WS_RSTD1 = 512 * 1024;
constexpr size_t WS_RSTD2 = 576 * 1024;
constexpr size_t WS_GL = 640 * 1024;
constexpr size_t WS_WINT = 2 * MiB;
constexpr size_t WS_WOUTT = 8 * MiB;
constexpr size_t WS_WQT = 10 * MiB;
constexpr size_t WS_GATE = 14 * MiB;
constexpr size_t WS_R1 = 16 * MiB;
constexpr size_t WS_R2 = 48 * MiB;
constexpr size_t WS_R3 = 72 * MiB;
constexpr size_t WS_R4 = 120 * MiB;
constexpr size_t WS_R5 = 136 * MiB;
constexpr size_t WS_R6 = 156 * MiB;
constexpr size_t WS_H2B = WS_R6;
constexpr size_t WS_DNT = 104 * MiB;
constexpr size_t WS_UPT = 228 * MiB;
constexpr size_t WS_QRY = 40 * MiB;
constexpr size_t WS_IDX = 120 * MiB;
constexpr size_t WS_GATES = 128 * MiB;
constexpr size_t WS_END = 244 * MiB;
constexpr int DN_UNIT_BYTES = 73728;
constexpr int LDS_BYTES = 144 * 1024;
constexpr float PEER_SC_D = 256.0f, PEER_SC_U = 64.0f;
constexpr size_t PEER_SLICE = 16384 * 128;

DI unsigned f2bf(float f) { unsigned u = __float_as_uint(f); return (u + 0x7fffu + ((u >> 16) & 1u)) >> 16; }
typedef __bf16 bf16x2_t __attribute__((ext_vector_type(2)));
DI unsigned pk2(float lo, float hi) { const f32x2 v = {lo, hi}; return __builtin_bit_cast(unsigned, __builtin_convertvector(v, bf16x2_t)); }
DI float bflo(unsigned w) { return __uint_as_float(w << 16); }
DI float bfhi(unsigned w) { return __uint_as_float(w & 0xffff0000u); }
DI float bf2f(bf16_t h) { return __uint_as_float(((unsigned)h) << 16); }
DI float wave_sum(float v) {
#pragma unroll
    for (int o = 32; o > 0; o >>= 1) v += __shfl_xor(v, o);
    return v;
}
template <int CTRL> DI float dppf(float v) { return __int_as_float(__builtin_amdgcn_update_dpp(0, __float_as_int(v), CTRL, 0xf, 0xf, true)); }
DI float wave_sum_dpp(float v) {
    v += dppf<0xB1>(v);
    v += dppf<0x4E>(v);
    v += dppf<0x141>(v);
    v += dppf<0x140>(v);
    const int iv = __float_as_int(v);
    return (__int_as_float(__builtin_amdgcn_readlane(iv, 0)) + __int_as_float(__builtin_amdgcn_readlane(iv, 16))) + (__int_as_float(__builtin_amdgcn_readlane(iv, 32)) + __int_as_float(__builtin_amdgcn_readlane(iv, 48)));
}
DI f32x4 mfma16(bf16x8 a, bf16x8 b, f32x4 c) { return __builtin_amdgcn_mfma_f32_16x16x32_bf16(a, b, c, 0, 0, 0); }
DI f32x16 mfma32(bf16x8 a, bf16x8 b, f32x16 c) { return __builtin_amdgcn_mfma_f32_32x32x16_bf16(a, b, c, 0, 0, 0); }
DI bf16x8 pack8(f32x4 a, f32x4 b) {
    u32x4 p; p.x = pk2(a[0], a[1]); p.y = pk2(a[2], a[3]); p.z = pk2(b[0], b[1]); p.w = pk2(b[2], b[3]);
    return __builtin_bit_cast(bf16x8, p);
}
DI bf16x8 cat8(u32x2 a, u32x2 b) { u32x4 p; p.x = a.x; p.y = a.y; p.z = b.x; p.w = b.y; return __builtin_bit_cast(bf16x8, p); }
DI int opaque_tid() { int t = threadIdx.x; asm volatile("" : "+v"(t)); return t; }
DI __amdgpu_buffer_rsrc_t wt_rsrc(const void* base) { return __builtin_amdgcn_make_buffer_rsrc((void*)base, 0, 0x7fffffff, 0x00020000); }
DI void wt_store16(__amdgpu_buffer_rsrc_t r, unsigned byte_off, u32x4 v) { __builtin_amdgcn_raw_buffer_store_b128(v, r, byte_off, 0, 16); }
DI float sigmoidf_(float x) { return __builtin_amdgcn_rcpf(1.0f + __expf(-x)); }
DI float siluf_(float x) { return x * __builtin_amdgcn_rcpf(1.0f + __expf(-x)); }

#define XB_TMO      128
#define XB_XCNT(j)  (256  + 64 * (j))
#define XB_XSUB(j)  (1280 + 64 * (j))
#define XB_XGEN(j)  (2304 + 64 * (j))
#define XB_TOP      3328
#define XB_TOPGEN   3392
#define XCD_BAR_WORDS 3456
#define XB_SPIN_CAP (1u << 22)
DI unsigned xb_ld(unsigned* p)              { return __hip_atomic_load(p, __ATOMIC_RELAXED, __HIP_MEMORY_SCOPE_AGENT); }
DI unsigned xb_add(unsigned* p, unsigned v) { return __hip_atomic_fetch_add(p, v, __ATOMIC_RELAXED, __HIP_MEMORY_SCOPE_AGENT); }
DI unsigned xb_xcc_id() { return (unsigned)__builtin_amdgcn_s_getreg((3 << 11) | 20) & 0xFu; }
#define XB_SPIN(cond, bar) do { unsigned _sp = 0; while (cond) { if (_sp < 64u) __builtin_amdgcn_s_sleep(2); else __builtin_amdgcn_s_sleep(24); \
    if ((++_sp & 255u) == 0u) { if (xb_ld(&(bar)[XB_TMO])) break; if (_sp > XB_SPIN_CAP) { atomicAdd(&(bar)[XB_TMO], 1u); break; } } } } while (0)
struct XcdBarrier { unsigned* bar; unsigned x; volatile LAS unsigned* st; };
DI XcdBarrier xcd_barrier_post(unsigned* bar, volatile LAS unsigned* st) {
    XcdBarrier b; b.bar = bar; b.x = xb_xcc_id(); b.st = st;
    if (threadIdx.x == 0) (void)xb_add(&bar[XB_XCNT(b.x)], 1u);
    return b;
}
DI void xcd_barrier_complete(unsigned* bar, unsigned x, unsigned& nloc, unsigned& nx) {
    const unsigned G = gridDim.x * gridDim.y * gridDim.z;
    unsigned sum, cnt, mine, sp = 0u;
    for (;;) {
        sum = 0u; cnt = 0u; mine = 0u;
#pragma unroll
        for (unsigned j = 0; j < 16; ++j) { const unsigned c = xb_ld(&bar[XB_XCNT(j)]); sum += c; cnt += (c > 0u) ? 1u : 0u; mine = (j == x) ? c : mine; }
        if (sum == G) break;
        __builtin_amdgcn_s_sleep(1);
        if ((++sp & 255u) == 0u) { if (xb_ld(&bar[XB_TMO])) break; if (sp > XB_SPIN_CAP) { atomicAdd(&bar[XB_TMO], 1u); break; } }
    }
    nloc = mine > 0u ? mine : 1u; nx = cnt > 0u ? cnt : 1u;
}
DI void xcd_barrier(const XcdBarrier& b) {
    asm volatile("s_waitcnt vmcnt(0)" ::: "memory");
    __syncthreads();
    if (threadIdx.x == 0) {
        unsigned* bar = b.bar;
        __builtin_amdgcn_s_waitcnt(0);
        unsigned nloc = b.st[0], nx = b.st[1];
        if (nloc == 0u) { xcd_barrier_complete(bar, b.x, nloc, nx); b.st[0] = nloc; b.st[1] = nx; }
        const unsigned old = xb_add(&bar[XB_XSUB(b.x)], 1u);
        const unsigned gen = old / nloc;
        if (old + 1u == (gen + 1u) * nloc) {
            __builtin_amdgcn_fence(__ATOMIC_RELEASE, "agent");
            asm volatile("s_waitcnt vmcnt(0)" ::: "memory");
            const unsigned og = xb_add(&bar[XB_TOP], 1u);
            const unsigned tg = og / nx;
            if (og + 1u == (tg + 1u) * nx) xb_add(&bar[XB_TOPGEN], 1u);
            else XB_SPIN(xb_ld(&bar[XB_TOPGEN]) == tg, bar);
            __builtin_amdgcn_fence(__ATOMIC_ACQUIRE, "agent");
            xb_add(&bar[XB_XGEN(b.x)], 1u);
            asm volatile("s_waitcnt vmcnt(0)" ::: "memory");
        } else {
            XB_SPIN(xb_ld(&bar[XB_XGEN(b.x)]) == gen, bar);
            __builtin_amdgcn_fence(__ATOMIC_ACQUIRE, "agent");
            asm volatile("s_waitcnt vmcnt(0)" ::: "memory");
        }
    }
    __syncthreads();
}

struct Args { const float* in[17]; float* out; unsigned char* ws; int ph_lo, ph_hi; };
enum { I_X = 0, I_N1W, I_WIN, I_QNW, I_KNW, I_SINK, I_CONVW, I_ALOG, I_DTB, I_DNNORM, I_WOUT, I_N2W, I_WQ, I_SK1, I_SK2, I_EDOWN, I_EUP };

DI void p0_transpose_item(const float* W, int ldw, const float* scale, bf16_t* WT, int kt, int nt, LAS float* tile, int lane) {
    float v[64];
    const float* src = W + (size_t)(kt * 64) * ldw + nt * 64 + lane;
#pragma unroll
    for (int r = 0; r < 64; ++r) v[r] = src[(size_t)r * ldw];
    if (scale) {
#pragma unroll
        for (int r = 0; r < 64; ++r) v[r] *= scale[kt * 64 + r];
    }
#pragma unroll
    for (int r = 0; r < 64; ++r) tile[r * 65 + lane] = v[r];
    const int kc = (lane & 7) * 8;
#pragma unroll
    for (int it = 0; it < 8; ++it) {
        const int n = (lane >> 3) + 8 * it;
        u32x4 w;
        w.x = pk2(tile[(kc + 0) * 65 + n], tile[(kc + 1) * 65 + n]);
        w.y = pk2(tile[(kc + 2) * 65 + n], tile[(kc + 3) * 65 + n]);
        w.z = pk2(tile[(kc + 4) * 65 + n], tile[(kc + 5) * 65 + n]);
        w.w = pk2(tile[(kc + 6) * 65 + n], tile[(kc + 7) * 65 + n]);
        *(u32x4*)(WT + (size_t)(nt * 64 + n) * 1024 + kt * 64 + kc) = w;
    }
}

DI void sincos_d(double a, double& s, double& c) {
    const double TWO_OVER_PI = 0.63661977236758134308, PIO2_HI = 1.57079632679489655800e+00, PIO2_LO = 6.12323399573676603587e-17;
    const double q = __builtin_rint(a * TWO_OVER_PI);
    double r = (a - q * PIO2_HI) - q * PIO2_LO;
    const int qi = (int)q & 3;
    const double r2 = r * r;
    double sp = r * (1.0 + r2 * (-1.0 / 6 + r2 * (1.0 / 120 + r2 * (-1.0 / 5040 + r2 * (1.0 / 362880 + r2 * (-1.0 / 39916800 + r2 * (1.0 / 6227020800.0)))))));
    double cp = 1.0 + r2 * (-0.5 + r2 * (1.0 / 24 + r2 * (-1.0 / 720 + r2 * (1.0 / 40320 + r2 * (-1.0 / 3628800 + r2 * (1.0 / 479001600.0 + r2 * (-1.0 / 87178291200.0)))))));
    double ss = (qi & 1) ? cp : sp, cc = (qi & 1) ? sp : cp;
    if (qi == 1) { cc = -cc; } else if (qi == 2) { ss = -ss; cc = -cc; } else if (qi == 3) { ss = -ss; }
    s = ss; c = cc;
}

DI void phase_prep(const Args& a, LAS unsigned char* lds, int bid, int G) {
    const int tid = opaque_tid(), lane = tid & 63, wid = tid >> 6;
    unsigned char* ws = a.ws;
    {
        LAS float* tile = (LAS float*)(lds + wid * (64 * 65 * 4));
        for (int it = bid * 8 + wid; it < 704 + 256 + 512; it += G * 8) {
            if (it < 704) p0_transpose_item(a.in[I_WIN], INW, a.in[I_N1W], (bf16_t*)(ws + WS_WINT), it / 44, it % 44, tile, lane);
            else if (it < 960) { const int j = it - 704; p0_transpose_item(a.in[I_WOUT], 1024, nullptr, (bf16_t*)(ws + WS_WOUTT), j / 16, j % 16, tile, lane); }
            else { const int j = it - 960; p0_transpose_item(a.in[I_WQ], 2048, a.in[I_N2W], (bf16_t*)(ws + WS_WQT), j / 32, j % 32, tile, lane); }
        }
    }
    {
        const int g = bid * NTHR + tid;
        if (g < 32768) {
            bf16_t* keys = (bf16_t*)(ws + WS_KEYS);
            const float v = (g < 16384) ? a.in[I_SK1][g] : a.in[I_SK2][g - 16384];
            keys[g] = (bf16_t)f2bf(v);
            const int pos = g >> 3, i = g & 7;
            const float inv_freq = powf(500000.0f, -((float)i * 2.0f / 16.0f));
            const float ang = (float)pos * inv_freq;
            double s, c; sincos_d((double)ang, s, c);
            float* rc = (float*)(ws + WS_ROPE);
            rc[g] = (float)c; rc[32768 + g] = (float)s;
        }
    }
    {
        LAS float* wg = (LAS float*)lds;
        __syncthreads();
        for (int e = tid; e < 8192; e += NTHR) { const int k = e >> 3, j = e & 7; wg[j * 1024 + k] = a.in[I_N1W][k] * a.in[I_WIN][(size_t)k * INW + NPROJ + j]; }
        __syncthreads();
        const float* x = a.in[I_X];
        bf16_t* xb = (bf16_t*)(ws + WS_R1);
        float* rstd1 = (float*)(ws + WS_RSTD1);
        float* gate = (float*)(ws + WS_GATE);
        float* ssq = (float*)(ws + WS_RSTD2);
        const int tstride = G * 8;
        f32x4 v[2][4], vnx[2][4];
        int tok = bid * 8 + wid;
#pragma unroll
        for (int k = 0; k < 2; ++k) { const int t = tok + k * tstride, tc = t < NTOK ? t : tok;
#pragma unroll
            for (int i = 0; i < 4; ++i) v[k][i] = ((const f32x4*)(x + (size_t)tc * DM))[lane + 64 * i]; }
        for (; tok < NTOK; tok += 2 * tstride) {
            const int tn = tok + 2 * tstride;
            if (tn < NTOK) {
#pragma unroll
                for (int k = 0; k < 2; ++k) { const int t = tn + k * tstride, tc = t < NTOK ? t : tn;
#pragma unroll
                    for (int i = 0; i < 4; ++i) vnx[k][i] = ((const f32x4*)(x + (size_t)tc * DM))[lane + 64 * i]; }
            }
#pragma unroll
            for (int k = 0; k < 2; ++k) {
                const int t = tok + k * tstride;
                float ss = 0.f, d[8];
#pragma unroll
                for (int j = 0; j < 8; ++j) d[j] = 0.f;
#pragma unroll
                for (int i = 0; i < 4; ++i) {
                    ss += v[k][i][0] * v[k][i][0] + v[k][i][1] * v[k][i][1] + v[k][i][2] * v[k][i][2] + v[k][i][3] * v[k][i][3];
#pragma unroll
                    for (int j = 0; j < 8; ++j) { const f32x4 w = *(const LAS f32x4*)(wg + j * 1024 + 4 * (lane + 64 * i)); d[j] += v[k][i][0] * w[0] + v[k][i][1] * w[1] + v[k][i][2] * w[2] + v[k][i][3] * w[3]; }
                }
                ss = wave_sum_dpp(ss);
#pragma unroll
                for (int j = 0; j < 8; ++j) d[j] = wave_sum_dpp(d[j]);
                const float rs = rsqrtf(ss * (1.0f / DM) + EPS);
                if (t < NTOK) {
#pragma unroll
                    for (int i = 0; i < 4; ++i) { u32x2 w; w.x = pk2(v[k][i][0], v[k][i][1]); w.y = pk2(v[k][i][2], v[k][i][3]); *(u32x2*)(xb + (size_t)t * DM + 4 * (lane + 64 * i)) = w; }
                    float dl = d[0];
#pragma unroll
                    for (int j = 1; j < 8; ++j) dl = (lane == j) ? d[j] : dl;
                    if (lane < 8) gate[t * 8 + lane] = rs * dl;
                    if (lane == 0) { rstd1[t] = rs; ssq[t] = 0.f; }
                }
            }
#pragma unroll
            for (int k = 0; k < 2; ++k)
#pragma unroll
                for (int i = 0; i < 4; ++i) v[k][i] = vnx[k][i];
        }
    }
}

namespace pg8 {
#define PG8_LAS __attribute__((address_space(3)))
typedef unsigned short bf16_t;
typedef short bf16x8 __attribute__((ext_vector_type(8)));
typedef float f32x4 __attribute__((ext_vector_type(4)));
typedef unsigned u32x4 __attribute__((ext_vector_type(4)));
constexpr int BM = 256, BK = 64, HALF = 128, HTB = HALF * BK * 2  , STAGE_BYTES = 8 * HTB, NXCD = 8, WGM = 8;

__host__ __device__ __forceinline__ int lds_byte(int r, int c) { const int st = (r >> 4) * 2 + (c >> 5), rr = r & 15, cc = c & 31, ob = rr * 64 + cc * 2; return st * 1024 + (ob ^ (((ob >> 9) & 1) << 5)); }
__host__ __device__ __forceinline__ void stage_rc(int b, int& R, int& C) { const int st = b / 1024, sb = b % 1024, swz = sb ^ (((sb >> 9) & 1) << 5); R = (st >> 1) * 16 + swz / 64; C = (st & 1) * 32 + (swz % 64) / 2; }
__host__ __device__ __forceinline__ int perm32(int rho) { const int n = rho >> 4, i = rho & 15; return 8 * (i >> 2) + 4 * n + (i & 3); }

struct Unit { int pm, pn; };
struct Gemm { const bf16_t* A; const bf16_t* Bt; int M, N, K; };

struct StaticOrder {
    int nM, nN, nwg, G, c;
    __host__ __device__ void init(int M, int N, int G_, int c_) { nM = M / BM; nN = N / BM; nwg = nM * nN; G = G_; c = c_; }
    __host__ __device__ bool next(int i, Unit& u) const {
        const long L = (long)i * G + c; if (L >= nwg) return false;
        int wgid = (int)L; { const int q = nwg / NXCD, r = nwg % NXCD, xcd = wgid % NXCD, off = wgid / NXCD; wgid = (xcd < r ? xcd * (q + 1) : r * (q + 1) + (xcd - r) * q) + off; }
        const int nig = WGM * nN, gid = wgid / nig, fm = gid * WGM, gsz = (nM - fm) < WGM ? (nM - fm) : WGM;
        u.pm = fm + ((wgid % nig) % gsz); u.pn = (wgid % nig) / gsz; return true;
    }
    __device__ __forceinline__ void a_ready(const Unit&) const {}
    __device__ __forceinline__ void done(const Unit&) const {}
};
__device__ __forceinline__ unsigned cvt_pk_bf16(float lo, float hi) { unsigned r; asm volatile("v_cvt_pk_bf16_f32 %0, %1, %2" : "=v"(r) : "v"(lo), "v"(hi)); return r; }
struct EpiProj {
    static constexpr bool PERM = true, AFTER_DRAIN = false;
    bf16_t* att; bf16_t* dqkv; bf16_t* gate; const float* rstd;
    __device__ __forceinline__ void operator()(const f32x4 (&acc)[2][2][4][2], const Unit& u, int wr, int wc, int fr, int fq) const {
        bf16_t* base; int ld, c0;
        if (u.pn < 3) { base = att; ld = 768; c0 = u.pn * 256; } else if (u.pn < 9) { base = dqkv; ld = 1536; c0 = (u.pn - 3) * 256; } else { base = gate; ld = 512; c0 = (u.pn - 9) * 256; }
        const int row0 = u.pm * BM + wr * 64 + fr, col0 = c0 + wc * 32 + 8 * fq;
        const __amdgpu_buffer_rsrc_t rs_out = wt_rsrc(base);
#pragma unroll
        for (int ai = 0; ai < 2; ++ai)
#pragma unroll
            for (int m = 0; m < 4; ++m) {
                const int row = row0 + ai * HALF + m * 16; const float rs = rstd[row];
                const unsigned boff = (unsigned)(((size_t)row * ld + col0) * 2);
#pragma unroll
                for (int bj = 0; bj < 2; ++bj) { const f32x4 v0 = acc[ai][bj][m][0] * rs, v1 = acc[ai][bj][m][1] * rs; u32x4 w; w.x = cvt_pk_bf16(v0[0], v0[1]); w.y = cvt_pk_bf16(v0[2], v0[3]); w.z = cvt_pk_bf16(v1[0], v1[1]); w.w = cvt_pk_bf16(v1[2], v1[3]);
                    wt_store16(rs_out, boff + bj * HALF * 2, w); }
            }
    }
};
struct EpiOut {
    static constexpr bool PERM = true, AFTER_DRAIN = false;
    const float* x; float* out; bf16_t* h2b; float* ssq;
    __device__ __forceinline__ void operator()(const f32x4 (&acc)[2][2][4][2], const Unit& u, int wr, int wc, int fr, int fq) const {
        const int row0 = u.pm * BM + wr * 64 + fr, col0 = u.pn * BM + wc * 32 + 8 * fq;
        const __amdgpu_buffer_rsrc_t rs_h2b = wt_rsrc(h2b);
#pragma unroll
        for (int ai = 0; ai < 2; ++ai)
#pragma unroll
            for (int m = 0; m < 4; ++m) {
                const size_t off = (size_t)(row0 + ai * HALF + m * 16) * 1024 + col0;
                float sq = 0.f;
#pragma unroll
                for (int bj = 0; bj < 2; ++bj) {
                    const f32x4 v0 = *(const f32x4*)(x + off + bj * HALF) + acc[ai][bj][m][0], v1 = *(const f32x4*)(x + off + bj * HALF + 4) + acc[ai][bj][m][1];
                    u32x4 w; w.x = cvt_pk_bf16(v0[0], v0[1]); w.y = cvt_pk_bf16(v0[2], v0[3]); w.z = cvt_pk_bf16(v1[0], v1[1]); w.w = cvt_pk_bf16(v1[2], v1[3]);
                    wt_store16(rs_h2b, (unsigned)((off + bj * HALF) * 2), w);
                    sq += (v0[0] * v0[0] + v0[1] * v0[1]) + (v0[2] * v0[2] + v0[3] * v0[3]) + (v1[0] * v1[0] + v1[1] * v1[1]) + (v1[2] * v1[2] + v1[3] * v1[3]);
                }
                sq += __shfl_xor(sq, 16); sq += __shfl_xor(sq, 32);
                if (fq == 0) atomicAdd(ssq + row0 + ai * HALF + m * 16, sq);
            }
    }
};
struct EpiQry {
    static constexpr bool PERM = true, AFTER_DRAIN = false;
    bf16_t* q;
    __device__ __forceinline__ void operator()(const f32x4 (&acc)[2][2][4][2], const Unit& u, int wr, int wc, int fr, int fq) const {
        const int row0 = u.pm * BM + wr * 64 + fr, col0 = u.pn * BM + wc * 32 + 8 * fq;
        const __amdgpu_buffer_rsrc_t rs_q = wt_rsrc(q);
#pragma unroll
        for (int ai = 0; ai < 2; ++ai)
#pragma unroll
            for (int m = 0; m < 4; ++m) {
                const unsigned boff = (unsigned)(((size_t)(row0 + ai * HALF + m * 16) * 2048 + col0) * 2);
#pragma unroll
                for (int bj = 0; bj < 2; ++bj) { const f32x4 v0 = acc[ai][bj][m][0], v1 = acc[ai][bj][m][1]; u32x4 w; w.x = cvt_pk_bf16(v0[0], v0[1]); w.y = cvt_pk_bf16(v0[2], v0[3]); w.z = cvt_pk_bf16(v1[0], v1[1]); w.w = cvt_pk_bf16(v1[2], v1[3]);
                    wt_store16(rs_q, boff + bj * HALF * 2, w); }
            }
    }
};
template <class Epi, class Sched, bool ALIGN_EPI = false, bool SP2 = false>
__device__ __forceinline__ void gemm_phase(PG8_LAS unsigned char* lds, const Gemm g, const Sched& S, const Epi& E) {
    const int tid = opaque_tid(), wid = __builtin_amdgcn_readfirstlane(tid >> 6), lane = tid & 63, wr = wid >> 2, wc = wid & 3, fr = lane & 15, fq = lane >> 4;
    const int K = g.K, nt = K / BK;
    unsigned voffA[2], voffB[2];
#pragma unroll
    for (int i = 0; i < 2; ++i) { int R, C; stage_rc(tid * 16 + i * 8192, R, C); const int Rb = Epi::PERM ? ((R & ~31) + perm32(R & 31)) : R;
        voffA[i] = (unsigned)(R * K + C) * 2u; voffB[i] = (unsigned)(Rb * K + C) * 2u; }
    const size_t kstep = (size_t)(BK * 2);
    const size_t hstep = (size_t)HALF * K * 2;
    const size_t tstep = 2 * hstep;
    const unsigned ldsw = (unsigned)wid * 1024u;
    const int aoff = lds_byte(wr * 64 + fr, fq * 8), boff = lds_byte(wc * 32 + fr, fq * 8);
#define PG8_SA(b, h) (((b) * 2 + (h)) * HTB)
#define PG8_SB(b, h) ((4 + (b) * 2 + (h)) * HTB)
#define PG8_STAGE(bufoff, gbase, voff) do { _Pragma("unroll") for (int _i = 0; _i < 2; ++_i) \
        __builtin_amdgcn_global_load_lds((const unsigned*)((const char*)(gbase) + (voff)[_i]), (PG8_LAS unsigned*)(lds + (bufoff) + ldsw + _i * 8192), 16, 0, 0); } while (0)
#define PG8_LDA(dst, b, h) do { _Pragma("unroll") for (int m = 0; m < 4; ++m) _Pragma("unroll") for (int k = 0; k < 2; ++k) dst[m][k] = *(const PG8_LAS bf16x8*)(lds + PG8_SA(b, h) + aoff + m * 2048 + k * 1024); } while (0)
#define PG8_LDB(dst, b, h) do { _Pragma("unroll") for (int n = 0; n < 2; ++n) _Pragma("unroll") for (int k = 0; k < 2; ++k) dst[n][k] = *(const PG8_LAS bf16x8*)(lds + PG8_SB(b, h) + boff + n * 2048 + k * 1024); } while (0)
#define PG8_MMA(ai, bj, At, Bt) do { __builtin_amdgcn_s_setprio(1); _Pragma("unroll") for (int m = 0; m < 4; ++m) _Pragma("unroll") for (int n = 0; n < 2; ++n) _Pragma("unroll") for (int k = 0; k < 2; ++k) \
        acc[ai][bj][m][n] = __builtin_amdgcn_mfma_f32_16x16x32_bf16(Bt[n][k], At[m][k], acc[ai][bj][m][n], 0, 0, 0); __builtin_amdgcn_s_setprio(0); } while (0)
#define PG8_WAIT_V(n) asm volatile("s_waitcnt vmcnt(" #n ")" ::: "memory")
#define PG8_WAIT_L(n) asm volatile("s_waitcnt lgkmcnt(" #n ")" ::: "memory")
#define PG8_BAR __builtin_amdgcn_s_barrier()
#define PG8_SCHED __builtin_amdgcn_sched_barrier(0)
    Unit cur, nxt; int ui = 0;
    if (!S.next(0, cur)) return;
    f32x4 acc[2][2][4][2];
#pragma unroll
    for (int a = 0; a < 2; ++a)
#pragma unroll
        for (int b = 0; b < 2; ++b)
#pragma unroll
            for (int m = 0; m < 4; ++m)
#pragma unroll
                for (int n = 0; n < 2; ++n) acc[a][b][m][n] = (f32x4){0.f, 0.f, 0.f, 0.f};
    bf16x8 At[4][2], B0[2][2], B1[2][2];
    const char* cA = (const char*)g.A + (size_t)cur.pm * tstep; const char* cB = (const char*)g.Bt + (size_t)cur.pn * tstep;
    S.a_ready(cur);
    if constexpr (SP2) {
        PG8_STAGE(PG8_SB(0, 0), cB, voffB); PG8_STAGE(PG8_SB(0, 1), cB + hstep, voffB); PG8_STAGE(PG8_SA(0, 0), cA, voffA); PG8_STAGE(PG8_SA(0, 1), cA + hstep, voffA);
        if (wr == 1) PG8_BAR;
        PG8_WAIT_V(2); PG8_BAR;
        PG8_STAGE(PG8_SB(1, 0), cB + kstep, voffB); PG8_STAGE(PG8_SA(1, 0), cA + kstep, voffA); PG8_STAGE(PG8_SB(1, 1), cB + hstep + kstep, voffB);
        PG8_WAIT_V(6); PG8_BAR;
    } else {
        PG8_STAGE(PG8_SB(0, 0), cB, voffB); PG8_STAGE(PG8_SA(0, 0), cA, voffA); PG8_STAGE(PG8_SB(0, 1), cB + hstep, voffB); PG8_STAGE(PG8_SA(0, 1), cA + hstep, voffA);
        if (wr == 1) PG8_BAR;
        PG8_WAIT_V(4); PG8_BAR;
        PG8_STAGE(PG8_SB(1, 0), cB + kstep, voffB); PG8_STAGE(PG8_SA(1, 0), cA + kstep, voffA); PG8_STAGE(PG8_SB(1, 1), cB + hstep + kstep, voffB);
        PG8_WAIT_V(6); PG8_BAR;
    }
    for (;;) {
        const bool has_next = S.next(ui + 1, nxt);
        const char* nA = has_next ? (const char*)g.A + (size_t)nxt.pm * tstep : cA; const char* nB = has_next ? (const char*)g.Bt + (size_t)nxt.pn * tstep : cB;
        for (int t = 0; t < nt; t += 2) {
            const bool last = (t == nt - 2);
            const char* a1 = cA + (size_t)(t + 1) * kstep;
            const char* a2 = last ? nA : cA + (size_t)(t + 2) * kstep; const char* b2 = last ? nB : cB + (size_t)(t + 2) * kstep;
            const char* a3 = a2 + kstep; const char* b3 = b2 + kstep;
            if (last && has_next) S.a_ready(nxt);
            if constexpr (SP2) {
            PG8_LDB(B0, 0, 0); PG8_LDB(B1, 0, 1); PG8_SCHED; PG8_LDA(At, 0, 0); PG8_STAGE(PG8_SA(1, 1), a1 + hstep, voffA);
            PG8_WAIT_V(8); PG8_WAIT_L(0); PG8_BAR; PG8_MMA(0, 0, At, B0); PG8_MMA(0, 1, At, B1); PG8_BAR; PG8_SCHED;
            PG8_LDA(At, 0, 1); PG8_STAGE(PG8_SB(0, 0), b2, voffB); PG8_STAGE(PG8_SB(0, 1), b2 + hstep, voffB); PG8_STAGE(PG8_SA(0, 0), a2, voffA);
            PG8_WAIT_V(8); PG8_WAIT_L(0); PG8_BAR; PG8_MMA(1, 0, At, B0); PG8_MMA(1, 1, At, B1); PG8_BAR; PG8_SCHED;
            PG8_LDB(B0, 1, 0); PG8_LDB(B1, 1, 1); PG8_SCHED; PG8_LDA(At, 1, 0); PG8_STAGE(PG8_SA(0, 1), a2 + hstep, voffA);
            PG8_WAIT_V(8); PG8_WAIT_L(0); PG8_BAR; PG8_MMA(0, 0, At, B0); PG8_MMA(0, 1, At, B1); PG8_BAR; PG8_SCHED;
            PG8_LDA(At, 1, 1); PG8_STAGE(PG8_SB(1, 0), b3, voffB); PG8_STAGE(PG8_SB(1, 1), b3 + hstep, voffB); PG8_STAGE(PG8_SA(1, 0), a3, voffA);
            PG8_WAIT_V(8); PG8_WAIT_L(0); PG8_BAR; PG8_MMA(1, 0, At, B0); PG8_MMA(1, 1, At, B1); PG8_BAR; PG8_SCHED;
            } else {
            PG8_LDB(B0, 0, 0); PG8_SCHED; PG8_LDA(At, 0, 0); PG8_STAGE(PG8_SA(1, 1), a1 + hstep, voffA);
            PG8_WAIT_L(8); PG8_BAR; PG8_WAIT_L(0); PG8_MMA(0, 0, At, B0); PG8_BAR; PG8_SCHED;
            PG8_LDB(B1, 0, 1); PG8_STAGE(PG8_SB(0, 0), b2, voffB);
            PG8_BAR; PG8_WAIT_L(0); PG8_MMA(0, 1, At, B1); PG8_BAR;
            PG8_LDA(At, 0, 1); PG8_STAGE(PG8_SA(0, 0), a2, voffA);
            PG8_BAR; PG8_WAIT_L(0); PG8_MMA(1, 0, At, B0); PG8_BAR; PG8_SCHED;
            PG8_STAGE(PG8_SB(0, 1), b2 + hstep, voffB);
            PG8_WAIT_V(6); PG8_BAR; PG8_MMA(1, 1, At, B1); PG8_BAR;
            PG8_LDB(B0, 1, 0); PG8_SCHED; PG8_LDA(At, 1, 0); PG8_STAGE(PG8_SA(0, 1), a2 + hstep, voffA);
            PG8_WAIT_L(8); PG8_BAR; PG8_WAIT_L(0); PG8_MMA(0, 0, At, B0); PG8_BAR; PG8_SCHED;
            PG8_LDB(B1, 1, 1); PG8_STAGE(PG8_SB(1, 0), b3, voffB);
            PG8_BAR; PG8_WAIT_L(0); PG8_MMA(0, 1, At, B1); PG8_BAR;
            PG8_LDA(At, 1, 1); PG8_STAGE(PG8_SA(1, 0), a3, voffA);
            PG8_BAR; PG8_WAIT_L(0); PG8_MMA(1, 0, At, B0); PG8_BAR; PG8_SCHED;
            PG8_STAGE(PG8_SB(1, 1), b3 + hstep, voffB);
            PG8_WAIT_V(6); PG8_BAR; PG8_MMA(1, 1, At, B1); PG8_BAR;
            }
        }
        if constexpr (ALIGN_EPI) { if (wr == 0) PG8_BAR; }
        if constexpr (!Epi::AFTER_DRAIN) { E(acc, cur, wr, wc, fr, fq); S.done(cur); }
        if (!has_next) break;
#pragma unroll
        for (int a = 0; a < 2; ++a)
#pragma unroll
            for (int b = 0; b < 2; ++b)
#pragma unroll
                for (int m = 0; m < 4; ++m)
#pragma unroll
                    for (int n = 0; n < 2; ++n) acc[a][b][m][n] = (f32x4){0.f, 0.f, 0.f, 0.f};
        cur = nxt; cA = nA; cB = nB; ++ui;
        if constexpr (ALIGN_EPI) { if (wr == 1) PG8_BAR; }
    }
    PG8_WAIT_V(0);
    if constexpr (!ALIGN_EPI) { if (wr == 0) PG8_BAR; }
    PG8_BAR;
    if constexpr (Epi::AFTER_DRAIN) { E.fused(acc, cur, wr, wc, fr, fq, lds, wid, lane); S.done(cur); }
#undef PG8_SA
#undef PG8_SB
#undef PG8_STAGE
#undef PG8_LDA
#undef PG8_LDB
#undef PG8_MMA
#undef PG8_WAIT_V
#undef PG8_WAIT_L
#undef PG8_BAR
#undef PG8_SCHED
}
}

DI void phase_qknorm(const Args& a, int bid, int G) {
    const int tid = opaque_tid();
    unsigned char* ws = a.ws;
    const bf16_t* patt = (const bf16_t*)(ws + WS_R2);
    bf16_t* Qn = (bf16_t*)(ws + WS_R5);
    bf16_t* Kn = Qn + (size_t)NTOK * 512;
    const float* rc = (const float*)(ws + WS_ROPE);
    const int sub = tid & 15;
    const int stride = (G * NTHR) >> 4, NIT = NTOK * 10;
    f32x4 nwq, nwk;
    nwq = *(const f32x4*)(a.in[I_QNW] + 4 * sub); nwk = *(const f32x4*)(a.in[I_KNW] + 4 * sub);
    for (int item0 = (bid * NTHR + tid) >> 4; item0 < NIT; item0 += 4 * stride) {
        u32x2 raw[4];
#pragma unroll
        for (int k = 0; k < 4; ++k) {
            const int item = item0 + k * stride, ic = item < NIT ? item : item0;
            raw[k] = *(const u32x2*)(patt + (size_t)(ic / 10) * 768 + (ic % 10) * 64 + 4 * sub);
        }
#pragma unroll
        for (int k = 0; k < 4; ++k) {
            const int item = item0 + k * stride, ic = item < NIT ? item : item0;
            const int tok = ic / 10, hh = ic % 10, pos = tok & (SEQ - 1);
            float v[4] = {bflo(raw[k].x), bfhi(raw[k].x), bflo(raw[k].y), bfhi(raw[k].y)};
            float ss = v[0] * v[0] + v[1] * v[1] + v[2] * v[2] + v[3] * v[3];
            ss += dppf<0xB1>(ss); ss += dppf<0x4E>(ss); ss += dppf<0x141>(ss); ss += dppf<0x140>(ss);
            const float rs = rsqrtf(ss * (1.0f / 64.0f) + EPS);
            const f32x4 nw = (hh < 8) ? nwq : nwk;
            float y[4], p[4];
#pragma unroll
            for (int e = 0; e < 4; ++e) y[e] = v[e] * rs * nw[e];
#pragma unroll
            for (int e = 0; e < 4; ++e) p[e] = dppf<0x4E>(y[e]);
            if (sub < 4) {
                const f32x4 c4 = *(const f32x4*)(rc + pos * 8 + 4 * (sub & 1)), s4 = *(const f32x4*)(rc + 32768 + pos * 8 + 4 * (sub & 1));
#pragma unroll
                for (int e = 0; e < 4; ++e) y[e] = (sub < 2) ? (y[e] * c4[e] - p[e] * s4[e]) : (y[e] * c4[e] + p[e] * s4[e]);
            }
            const float sc = (hh < 8) ? 0.125f : 1.0f;
            u32x2 w; w.x = pk2(y[0] * sc, y[1] * sc); w.y = pk2(y[2] * sc, y[3] * sc);
            if (item < NIT) {
                if (hh < 8) *(u32x2*)(Qn + (size_t)tok * 512 + hh * 64 + 4 * sub) = w;
                else *(u32x2*)(Kn + (size_t)tok * 128 + (hh - 8) * 64 + 4 * sub) = w;
            }
        }
    }
}

constexpr int DP_ROW = 272;
constexpr int DP_IMG = 64 * DP_ROW;
constexpr int DP_HALF = 4 * DP_IMG;
constexpr int DP_SMALL = 2 * DP_HALF;
DI void phase_dnprep(const Args& a, LAS unsigned char* lds, int bid, int G) {
    unsigned char* ws = a.ws;
    const bf16_t* pd = (const bf16_t*)(ws + WS_R3);
    const float* gate = (const float*)(ws + WS_GATE);
    const float* cw = a.in[I_CONVW];
    for (int up = bid; up < 512; up += G) {
        int tid = threadIdx.x;
        asm volatile("" : "+v"(tid));
        const int half = tid >> 8, ht = tid & 255, lane = tid & 63, hw = ht >> 6, fr = lane & 15, fq = lane >> 4;
        LAS unsigned char* qs = lds + half * DP_HALF;
        LAS unsigned char* ks = qs + DP_IMG;
        LAS unsigned char* vs = ks + DP_IMG;
        LAS float* Lm = (LAS float*)(vs + DP_IMG);
        LAS float* gc = (LAS float*)(lds + DP_SMALL + half * 512);
        LAS float* bt = gc + 64;
        LAS float* fb = (LAS float*)(lds + DP_SMALL + 1024 + half * 256);
        LAS float* eg = (LAS float*)(lds + DP_SMALL + 1536 + half * 512);
        LAS float* ek = eg + 64;
        const int unit = up * 2 + half;
        const int n = unit & 63, h = (unit >> 6) & 3, b = unit >> 8;
        const int c0 = n * 64, tok0 = b * SEQ + c0;
        unsigned char* ub = ws + WS_R6 + (size_t)unit * DN_UNIT_BYTES;
        __syncthreads();
#ifndef DP_S1
#define DP_S1 1
#define DP_S2 1
#define DP_S3 1
#endif
#pragma unroll 1
        for (int r1_ = 0; r1_ < DP_S1; ++r1_) {
            unsigned raw[3][19];
#pragma unroll
            for (int which = 0; which < 3; ++which) {
                const int cb = which * 512 + h * 128 + 2 * lane;
#pragma unroll
                for (int r = 0; r < 19; ++r) {
                    const int t = c0 + 16 * hw - 3 + r;
                    raw[which][r] = (t >= 0) ? *(const unsigned*)(pd + (size_t)(b * SEQ + (t >= 0 ? t : 0)) * 1536 + cb) : 0u;
                }
            }
#pragma unroll
            for (int which = 0; which < 3; ++which) {
                const int cb = which * 512 + h * 128 + 2 * lane;
                float w0[4], w1[4];
#pragma unroll
                for (int j = 0; j < 4; ++j) { const f32x2 w = *(const f32x2*)(cw + j * 1536 + cb); w0[j] = w[0]; w1[j] = w[1]; }
                LAS unsigned char* img = qs + which * DP_IMG;
#pragma unroll
                for (int ii = 0; ii < 16; ++ii) {
                    float y0 = 0.f, y1 = 0.f;
#pragma unroll
                    for (int j = 0; j < 4; ++j) { y0 += w0[j] * bflo(raw[which][ii + j]); y1 += w1[j] * bfhi(raw[which][ii + j]); }
                    y0 = siluf_(y0); y1 = siluf_(y1);
                    if (which < 2) {
                        const float ss = wave_sum_dpp(y0 * y0 + y1 * y1);
                        float sc = rsqrtf(ss + EPS);
                        if (which == 0) sc *= 0.08838834764831845f;
                        y0 *= sc; y1 *= sc;
                    }
                    *(LAS unsigned*)(img + (16 * hw + ii) * DP_ROW + 4 * lane) = pk2(y0, y1);
                }
            }
        }
        if (hw == 0) {
            const float bb = gate[(size_t)(tok0 + lane) * 8 + h], aa = gate[(size_t)(tok0 + lane) * 8 + 4 + h];
            const float xx = aa + a.in[I_DTB][h];
            const float sp = (xx > 20.f) ? xx : log1pf(expf(xx));
            float g = -expf(a.in[I_ALOG][h]) * sp;
#pragma unroll
            for (int o = 1; o < 64; o <<= 1) { const float t = __shfl_up(g, o); if (lane >= o) g += t; }
            const float be = sigmoidf_(bb);
            const float eg_ = __expf(g), g63_ = __shfl(g, 63);
            gc[lane] = g; bt[lane] = be; fb[lane] = be * eg_; eg[lane] = eg_; ek[lane] = __expf(g63_ - g);
        }
        __syncthreads();
#pragma unroll 1
        for (int r2_ = 0; r2_ < DP_S2; ++r2_) {
            const int it = hw;
            const int i = 16 * it + fr;
            const float gi = gc[i], bi = bt[i];
            bf16_t* intra = (bf16_t*)(ub + 49152);
#pragma unroll
            for (int jp = 0; jp < 2; ++jp) {
                u32x4 wv;
#pragma unroll
                for (int jh = 0; jh < 2; ++jh) {
                    const int jt = 2 * jp + jh;
                    f32x4 akk = {0.f, 0.f, 0.f, 0.f}, aqk = {0.f, 0.f, 0.f, 0.f};
#pragma unroll
                    for (int s = 0; s < 4; ++s) {
                        const bf16x8 A = *(const LAS bf16x8*)(ks + (16 * jt + fr) * DP_ROW + s * 64 + fq * 16);
                        const bf16x8 Bk = *(const LAS bf16x8*)(ks + (16 * it + fr) * DP_ROW + s * 64 + fq * 16);
                        const bf16x8 Bq = *(const LAS bf16x8*)(qs + (16 * it + fr) * DP_ROW + s * 64 + fq * 16);
                        akk = mfma16(A, Bk, akk); aqk = mfma16(A, Bq, aqk);
                    }
                    f32x4 lv, iv;
#pragma unroll
                    for (int r = 0; r < 4; ++r) {
                        const int j = 16 * jt + 4 * fq + r;
                        const float dec = (j <= i) ? __expf(gi - gc[j]) : 0.f;
                        lv[r] = (j < i) ? bi * akk[r] * dec : 0.f;
                        iv[r] = aqk[r] * dec;
                    }
                    *(LAS f32x4*)(Lm + i * 68 + 16 * jt + 4 * fq) = lv;
                    if (jh == 0) { wv.x = pk2(iv[0], iv[1]); wv.y = pk2(iv[2], iv[3]); } else { wv.z = pk2(iv[0], iv[1]); wv.w = pk2(iv[2], iv[3]); }
                }
                *(u32x4*)(intra + i * 64 + 32 * jp + 8 * fq) = wv;
            }
        }
        __syncthreads();
        {
            const int j = lane & 15;
            const LAS float* Lb = Lm + (16 * hw) * 68 + 16 * hw;
            float t[16];
#pragma unroll
            for (int i = 0; i < 16; ++i) {
                float acc = (i == j) ? 1.f : 0.f;
#pragma unroll
                for (int k4 = 0; k4 < i; k4 += 4) {
                    const f32x4 l = *(const LAS f32x4*)(Lb + i * 68 + k4);
                    acc -= l[0] * t[k4];
                    if (k4 + 1 < i) acc -= l[1] * t[k4 + 1];
                    if (k4 + 2 < i) acc -= l[2] * t[k4 + 2];
                    if (k4 + 3 < i) acc -= l[3] * t[k4 + 3];
                }
                t[i] = acc;
            }
            asm volatile("s_waitcnt lgkmcnt(0)" ::: "memory");
#pragma unroll
            for (int i = 0; i < 16; ++i) *(LAS float*)(Lm + (16 * hw + i) * 68 + 16 * hw + j) = t[i];
        }
        __syncthreads();
        f32x4 U[4][4];
        {
            const LAS unsigned char* src = (hw < 2) ? (vs + 2 * (64 * hw)) : (ks + 2 * (64 * (hw - 2)));
            const LAS float* fac = (hw < 2) ? bt : fb;
            f32x4 R[4][4];
#pragma unroll
            for (int ct = 0; ct < 4; ++ct)
#pragma unroll
                for (int bb = 0; bb < 4; ++bb)
#pragma unroll
                    for (int r = 0; r < 4; ++r) { const int i = 16 * bb + 4 * fq + r; R[ct][bb][r] = bf2f(*(const LAS bf16_t*)(src + i * DP_ROW + 2 * (16 * ct + fr))) * fac[i]; }
            u32x2 Ub16[4][4];
#pragma unroll
            for (int bb = 0; bb < 4; ++bb) {
                f32x4 X[4];
#pragma unroll
                for (int ct = 0; ct < 4; ++ct) X[ct] = (f32x4){0.f, 0.f, 0.f, 0.f};
#pragma unroll
                for (int c = 0; c < bb; c += 2) {
                    const f32x4 a0 = *(const LAS f32x4*)(Lm + (16 * bb + fr) * 68 + 16 * c + 4 * fq);
                    f32x4 a1 = {0.f, 0.f, 0.f, 0.f};
                    if (c + 1 < bb) a1 = *(const LAS f32x4*)(Lm + (16 * bb + fr) * 68 + 16 * (c + 1) + 4 * fq);
                    const bf16x8 A = pack8(a0, a1);
#pragma unroll
                    for (int ct = 0; ct < 4; ++ct) {
                        const u32x2 z = {0u, 0u};
                        const bf16x8 B = cat8(Ub16[ct][c], (c + 1 < bb) ? Ub16[ct][c + 1] : z);
                        X[ct] = mfma16(A, B, X[ct]);
                    }
                }
                const f32x4 tv = *(const LAS f32x4*)(Lm + (16 * bb + fr) * 68 + 16 * bb + 4 * fq);
                const bf16x8 AT = pack8(tv, (f32x4){0.f, 0.f, 0.f, 0.f});
#pragma unroll
                for (int ct = 0; ct < 4; ++ct) {
                    const f32x4 Rp = R[ct][bb] - X[ct];
                    u32x2 rp16; rp16.x = pk2(Rp[0], Rp[1]); rp16.y = pk2(Rp[2], Rp[3]);
                    const u32x2 z = {0u, 0u};
                    const f32x4 Ub = mfma16(AT, cat8(rp16, z), (f32x4){0.f, 0.f, 0.f, 0.f});
                    U[ct][bb] = Ub;
                    Ub16[ct][bb].x = pk2(Ub[0], Ub[1]); Ub16[ct][bb].y = pk2(Ub[2], Ub[3]);
                }
            }
        }
        __syncthreads();
        LAS unsigned char* img_k = (LAS unsigned char*)Lm;
        {
            bf16_t* qd = (bf16_t*)(ub + 16384);
            const int c16 = ht & 15, cc = c16 >> 2, k = c16 & 3;
#pragma unroll
            for (int itr = 0; itr < 4; ++itr) {
                const int i = (ht >> 4) + 16 * itr;
                const float e = eg[i];
                const u32x2 r0 = *(const LAS u32x2*)(qs + i * DP_ROW + cc * 64 + k * 8), r1 = *(const LAS u32x2*)(qs + i * DP_ROW + cc * 64 + 32 + k * 8);
                u32x4 w;
                w.x = pk2(bflo(r0.x) * e, bfhi(r0.x) * e); w.y = pk2(bflo(r0.y) * e, bfhi(r0.y) * e);
                w.z = pk2(bflo(r1.x) * e, bfhi(r1.x) * e); w.w = pk2(bflo(r1.y) * e, bfhi(r1.y) * e);
                *(u32x4*)(qd + i * 128 + c16 * 8) = w;
            }
            const int d = ht & 127, ih = ht >> 7;
#pragma unroll
            for (int k2 = 0; k2 < 4; ++k2) {
                float v[8];
#pragma unroll
                for (int e2 = 0; e2 < 8; ++e2) { const int ii = 32 * ih + 16 * (e2 >> 2) + 4 * k2 + (e2 & 3); v[e2] = bf2f(*(const LAS bf16_t*)(ks + ii * DP_ROW + 2 * d)) * ek[ii]; }
                u32x4 w; w.x = pk2(v[0], v[1]); w.y = pk2(v[2], v[3]); w.z = pk2(v[4], v[5]); w.w = pk2(v[6], v[7]);
                *(LAS u32x4*)(img_k + d * 128 + (((4 * ih + k2) ^ (d & 7)) * 16)) = w;
            }
            if (ht == 0) ((float*)(ws + WS_GL))[unit] = eg[63];
            if (hw >= 2) {
#pragma unroll
                for (int ct = 0; ct < 4; ++ct) {
                    const int cc2 = 64 * (hw - 2) + 16 * ct + fr, cp = (cc2 & ~31) | (((cc2 >> 2) & 3) << 3) | (((cc2 >> 4) & 1) << 2) | (cc2 & 3);
#pragma unroll
                    for (int bb = 0; bb < 4; ++bb)
#pragma unroll
                        for (int r = 0; r < 4; ++r) *(LAS bf16_t*)(vs + (16 * bb + 4 * fq + r) * DP_ROW + 2 * cp) = (bf16_t)f2bf(U[ct][bb][r]);
                }
            }
        }
        __syncthreads();
        {
            if (hw < 2) {
#pragma unroll
                for (int ct = 0; ct < 4; ++ct) {
                    const int dv = 64 * hw + 16 * ct + fr;
#pragma unroll
                    for (int bb = 0; bb < 4; ++bb) {
                        u32x2 w; w.x = pk2(U[ct][bb][0], U[ct][bb][1]); w.y = pk2(U[ct][bb][2], U[ct][bb][3]);
                        *(LAS u32x2*)(qs + dv * 128 + (((2 * bb + (fq >> 1)) ^ (dv & 7)) * 16) + 8 * (fq & 1)) = w;
                    }
                }
            }
            bf16_t* kdT = (bf16_t*)(ub + 32768);
            bf16_t* wout = (bf16_t*)ub;
#pragma unroll
            for (int k = 0; k < 4; ++k) {
                const int cid = ht + 256 * k;
                { const int row = cid >> 3, c = cid & 7; *(u32x4*)(kdT + row * 64 + c * 8) = *(const LAS u32x4*)(img_k + row * 128 + ((c ^ (row & 7)) * 16)); }
                { const int row = cid >> 4, c16 = cid & 15; *(u32x4*)(wout + row * 128 + c16 * 8) = *(const LAS u32x4*)(vs + row * DP_ROW + c16 * 16); }
            }
        }
        __syncthreads();
        {
            bf16_t* uT = (bf16_t*)(ub + 57344);
#pragma unroll
            for (int k = 0; k < 4; ++k) {
                const int cid = ht + 256 * k, row = cid >> 3, c = cid & 7;
                *(u32x4*)(uT + row * 64 + c * 8) = *(const LAS u32x4*)(qs + row * 128 + ((c ^ (row & 7)) * 16));
            }
        }
    }
}

constexpr int AT_KROW = 144, AT_KSZ = 208 * AT_KROW;
constexpr int AT_VROW = 432;
DI void attn_unit(const Args& a, LAS unsigned char* lds, int unit) {
    const int tid = opaque_tid(), lane = tid & 63, wid = tid >> 6, fr = lane & 15, fq = lane >> 4;
    unsigned char* ws = a.ws;
    const bf16_t* Qn = (const bf16_t*)(ws + WS_R5);
    const bf16_t* Kn = Qn + (size_t)NTOK * 512;
    const bf16_t* patt = (const bf16_t*)(ws + WS_R2);
    bf16_t* mix = (bf16_t*)(ws + WS_R1);
    const int qh = unit & 1, hkv = (unit >> 1) & 1, blk = (unit >> 2) & 31, b = unit >> 7;
    const int Q0 = blk * 128 + qh * 64;
    LAS unsigned char* Ks = lds;
    LAS unsigned char* VT = lds + AT_KSZ;
    __syncthreads();
    for (int cid = tid; cid < 208 * 8; cid += NTHR) {
        const int kk = cid >> 3, c = cid & 7, key = Q0 - 128 + kk;
        u32x4 kv = {0u, 0u, 0u, 0u}, vv = {0u, 0u, 0u, 0u};
        if (key >= 0 && kk < 192) {
            kv = *(const u32x4*)(Kn + (size_t)(b * SEQ + key) * 128 + hkv * 64 + c * 8);
            vv = *(const u32x4*)(patt + (size_t)(b * SEQ + key) * 768 + 640 + hkv * 64 + c * 8);
        }
        *(LAS u32x4*)(Ks + kk * AT_KROW + c * 16) = kv;
        const unsigned vw[4] = {vv.x, vv.y, vv.z, vv.w};
#pragma unroll
        for (int e = 0; e < 4; ++e) {
            *(LAS bf16_t*)(VT + (c * 8 + 2 * e) * AT_VROW + 2 * kk) = (bf16_t)(vw[e] & 0xffffu);
            *(LAS bf16_t*)(VT + (c * 8 + 2 * e + 1) * AT_VROW + 2 * kk) = (bf16_t)(vw[e] >> 16);
        }
    }
    __syncthreads();
#pragma unroll 1
    for (int it = 0; it < 2; ++it) {
        const int wu = wid + 8 * it, g = wu & 3, i4 = wu >> 2, h = hkv * 4 + g;
        const int qpos = Q0 + 16 * i4 + fr;
        const size_t tok = (size_t)b * SEQ + qpos;
        bf16x8 bq[2];
#pragma unroll
        for (int s = 0; s < 2; ++s) bq[s] = *(const bf16x8*)(Qn + tok * 512 + h * 64 + 32 * s + 8 * fq);
        const float sink = a.in[I_SINK][h];
        f32x4 sc[10];
        float mx = -3.0e38f;
#pragma unroll
        for (int t = 0; t < 10; ++t) {
            f32x4 acc = {0.f, 0.f, 0.f, 0.f};
#pragma unroll
            for (int s = 0; s < 2; ++s) { const bf16x8 A = *(const LAS bf16x8*)(Ks + (16 * (i4 + t) + fr) * AT_KROW + s * 64 + fq * 16); acc = mfma16(A, bq[s], acc); }
#pragma unroll
            for (int r = 0; r < 4; ++r) {
                const int kpos = Q0 - 128 + 16 * (i4 + t) + 4 * fq + r;
                const bool valid = (kpos >= 0) && (kpos <= qpos) && (kpos >= qpos - 127);
                acc[r] = valid ? acc[r] : -3.0e38f;
                mx = fmaxf(mx, acc[r]);
            }
            sc[t] = acc;
        }
        mx = fmaxf(mx, __shfl_xor(mx, 16)); mx = fmaxf(mx, __shfl_xor(mx, 32));
        mx = fmaxf(mx, sink);
        float sum = 0.f;
#pragma unroll
        for (int t = 0; t < 10; ++t)
#pragma unroll
            for (int r = 0; r < 4; ++r) { const float p = (sc[t][r] > -1.0e38f) ? __expf(sc[t][r] - mx) : 0.f; sc[t][r] = p; sum += p; }
        sum += __shfl_xor(sum, 16); sum += __shfl_xor(sum, 32);
        const float inv = 1.0f / (sum + __expf(sink - mx));
        bf16x8 bp[5];
#pragma unroll
        for (int kp = 0; kp < 5; ++kp) bp[kp] = pack8(sc[2 * kp], sc[2 * kp + 1]);
#pragma unroll
        for (int mt = 0; mt < 4; ++mt) {
            f32x4 o = {0.f, 0.f, 0.f, 0.f};
#pragma unroll
            for (int kp = 0; kp < 5; ++kp) {
                const LAS unsigned char* vp = VT + (16 * mt + fr) * AT_VROW + 2 * (16 * (i4 + 2 * kp) + 4 * fq);
                const bf16x8 A = cat8(*(const LAS u32x2*)vp, *(const LAS u32x2*)(vp + 32));
                o = mfma16(A, bp[kp], o);
            }
            u32x2 w; w.x = pk2(o[0] * inv, o[1] * inv); w.y = pk2(o[2] * inv, o[3] * inv);
            *(u32x2*)(mix + tok * DM + h * 64 + 16 * mt + 4 * fq) = w;
        }
    }
}

#ifndef S2_PARTS
#define S2_PARTS 4
#endif
#ifndef TAB_SPLIT
#define TAB_SPLIT 15360
#endif
#ifndef UP_EARLY
#define UP_EARLY 8192
#endif
constexpr int S2_CW = 8 / S2_PARTS, S2_NBLK = 16 * S2_PARTS;
constexpr int S2_W = 0, S2_KD = 17408, S2_BUF = 17408 + 18432;
constexpr size_t WS_SB = WS_R3;
#define S2_GLOAD(rg_, n_) do { const unsigned char* ub_ = base + (size_t)(n_) * DN_UNIT_BYTES + (size_t)lt * 16; _Pragma("unroll") for (int i = 0; i < 8; ++i) \
        rg_[i] = *(const u32x4*)(ub_ + (i < 4 ? i * 4096 : 32768 + (i - 4) * 4096)); } while (0)
#define S2_LSTORE(rg_, buf_) do { _Pragma("unroll") for (int i = 0; i < 8; ++i) *(LAS u32x4*)(lds + (buf_) * S2_BUF + dst[i]) = rg_[i]; } while (0)
#define S2_ULOAD(u_, n_) do { const bf16_t* uT_ = (const bf16_t*)(base + (size_t)(n_) * DN_UNIT_BYTES + 57344) + (cbase + fr) * 64 + 4 * fq; \
        _Pragma("unroll") for (int m = 0; m < 4; ++m) u_[m] = *(const u32x2*)(uT_ + 16 * m); } while (0)
template <bool DO_ULOAD>
DI void scan2_step_compute(LAS unsigned char* lds, unsigned char* base, unsigned char* sbp, const float glv, int n,
                           const u32x2 (&uc)[4], u32x2 (&un)[4], f32x4 (&S)[8], bf16x8 (&BS)[4], int cbase, int fr, int fq, int lane) {
    const int buf = n & 1;
    if (DO_ULOAD) S2_ULOAD(un, n + 1);
    const LAS unsigned char* L = lds + buf * S2_BUF;
    const float gl = __int_as_float(__builtin_amdgcn_readlane(__float_as_int(glv), n));
    {
        unsigned char* p = sbp + (size_t)n * 32768 + lane * 16;
#pragma unroll
        for (int s = 0; s < 4; ++s) *(u32x4*)(p + s * 1024) = __builtin_bit_cast(u32x4, BS[s]);
    }
    const LAS unsigned char* Lw = L + S2_W + fr * 272 + 16 * fq;
    const LAS unsigned char* Lk = L + S2_KD + fr * 144 + 16 * fq;
#define RD_A(f_, Lx_, m_) do { _Pragma("unroll") for (int s_ = 0; s_ < 4; ++s_) { f_[s_] = *(const LAS bf16x8*)(Lx_ + (m_) * 16 * 272 + 64 * s_); f_[4 + s_] = *(const LAS bf16x8*)(Lx_ + ((m_) + 1) * 16 * 272 + 64 * s_); } } while (0)
#define MM_A(f_, X_, m_) do { _Pragma("unroll") for (int s_ = 0; s_ < 4; ++s_) { X_[m_] = mfma16(f_[s_], BS[s_], X_[m_]); X_[(m_) + 1] = mfma16(f_[4 + s_], BS[s_], X_[(m_) + 1]); } } while (0)
#define RD_KD(f_, t0_) do { _Pragma("unroll") for (int t_ = 0; t_ < 4; ++t_) { f_[2 * t_] = *(const LAS bf16x8*)(Lk + ((t0_) + t_) * 16 * 144); f_[2 * t_ + 1] = *(const LAS bf16x8*)(Lk + ((t0_) + t_) * 16 * 144 + 64); } } while (0)
#define MM_KD(f_, t0_) do { _Pragma("unroll") for (int t_ = 0; t_ < 4; ++t_) { S[(t0_) + t_] = mfma16(f_[2 * t_], BV[0], S[(t0_) + t_]); S[(t0_) + t_] = mfma16(f_[2 * t_ + 1], BV[1], S[(t0_) + t_]); } } while (0)
#define SB() __builtin_amdgcn_sched_barrier(0)
    f32x4 P[4];
#pragma unroll
    for (int m = 0; m < 4; ++m) P[m] = (f32x4){0.f, 0.f, 0.f, 0.f};
    bf16x8 fa[8], fb[8];
    RD_A(fa, Lw, 0); SB();
    RD_A(fb, Lw, 2); MM_A(fa, P, 0); SB();
    RD_KD(fa, 0);    MM_A(fb, P, 2); SB();
    f32x4 vn[4];
#pragma unroll
    for (int m = 0; m < 4; ++m) vn[m] = (f32x4){bflo(uc[m].x), bfhi(uc[m].x), bflo(uc[m].y), bfhi(uc[m].y)} - P[m];
    bf16x8 BV[2];
    BV[0] = pack8(vn[0], vn[1]); BV[1] = pack8(vn[2], vn[3]);
    {
        unsigned char* p = base + (size_t)n * DN_UNIT_BYTES + 57344 + (cbase >> 4) * 2048 + lane * 16;
        *(u32x4*)p = __builtin_bit_cast(u32x4, BV[0]); *(u32x4*)(p + 1024) = __builtin_bit_cast(u32x4, BV[1]);
    }
#pragma unroll
    for (int t = 0; t < 8; ++t) S[t] = S[t] * gl;
    RD_KD(fb, 4); MM_KD(fa, 0); SB();
    MM_KD(fb, 4);
#pragma unroll
    for (int s = 0; s < 4; ++s) BS[s] = pack8(S[2 * s], S[2 * s + 1]);
#undef RD_A
#undef MM_A
#undef RD_KD
#undef MM_KD
#undef SB
    __syncthreads();
}
template <bool DO_LSTORE, bool DO_GLOAD>
DI void scan2_step_load(LAS unsigned char* lds, const unsigned char* base, int n, const int (&dst)[8], u32x4 (&rr)[8], int lt) {
    const int buf = n & 1;
    if (DO_LSTORE) S2_LSTORE(rr, buf ^ 1);
    if (DO_GLOAD) S2_GLOAD(rr, n + 5);
    __syncthreads();
}
DI void scan2_unit(const Args& a, LAS unsigned char* lds, int sunit) {
    int tid = threadIdx.x;
    asm volatile("" : "+v"(tid));
    const int lane = tid & 63, wid = __builtin_amdgcn_readfirstlane(tid >> 6), fr = lane & 15, fq = lane >> 4;
    unsigned char* ws = a.ws;
    const int unit = sunit & 15, part = sunit >> 4, cbase = (128 / S2_PARTS) * part + 16 * (wid & (S2_CW - 1));
    unsigned char* base = ws + WS_R6 + (size_t)unit * 64 * DN_UNIT_BYTES;
    float glv = ((const float*)(ws + WS_GL))[unit * 64 + lane];
    asm volatile("v_mov_b32 %0, %0" : "+v"(glv));
    __syncthreads();
    if (wid < S2_CW) {
        unsigned char* sbp = ws + WS_SB + ((size_t)(unit * 64) * 8 + (cbase >> 4)) * 4096;
        f32x4 S[8]; bf16x8 BS[4]; u32x2 U0[4], U1[4];
#pragma unroll
        for (int t = 0; t < 8; ++t) S[t] = (f32x4){0.f, 0.f, 0.f, 0.f};
#pragma unroll
        for (int s = 0; s < 4; ++s) BS[s] = (bf16x8){0, 0, 0, 0, 0, 0, 0, 0};
        S2_ULOAD(U0, 0);
        __syncthreads();
#pragma unroll 1
        for (int n = 0; n < 62; n += 2) {
            scan2_step_compute<true>(lds, base, sbp, glv, n, U0, U1, S, BS, cbase, fr, fq, lane);
            scan2_step_compute<true>(lds, base, sbp, glv, n + 1, U1, U0, S, BS, cbase, fr, fq, lane);
        }
        scan2_step_compute<true>(lds, base, sbp, glv, 62, U0, U1, S, BS, cbase, fr, fq, lane);
        scan2_step_compute<false>(lds, base, sbp, glv, 63, U1, U0, S, BS, cbase, fr, fq, lane);
    } else if (wid < S2_CW + 4) {
        const int lt = tid - 64 * S2_CW;
        u32x4 R0[8], R1[8], R2[8], R3[8];
        int dst[8];
#pragma unroll
        for (int i = 0; i < 8; ++i) { const int g = lt + 256 * (i & 3); dst[i] = (i < 4) ? (S2_W + (g >> 4) * 272 + (g & 15) * 16) : (S2_KD + (g >> 3) * 144 + (g & 7) * 16); }
        S2_GLOAD(R0, 0); S2_GLOAD(R1, 1); S2_GLOAD(R2, 2); S2_GLOAD(R3, 3);
        S2_LSTORE(R0, 0);
        S2_GLOAD(R0, 4);
        __syncthreads();
#pragma unroll 1
        for (int n = 0; n < 56; n += 4) {
            scan2_step_load<true, true>(lds, base, n, dst, R1, lt);
            scan2_step_load<true, true>(lds, base, n + 1, dst, R2, lt);
            scan2_step_load<true, true>(lds, base, n + 2, dst, R3, lt);
            scan2_step_load<true, true>(lds, base, n + 3, dst, R0, lt);
        }
        scan2_step_load<true, true>(lds, base, 56, dst, R1, lt);
        scan2_step_load<true, true>(lds, base, 57, dst, R2, lt);
        scan2_step_load<true, true>(lds, base, 58, dst, R3, lt);
        scan2_step_load<true, false>(lds, base, 59, dst, R0, lt);
        scan2_step_load<true, false>(lds, base, 60, dst, R1, lt);
        scan2_step_load<true, false>(lds, base, 61, dst, R2, lt);
        scan2_step_load<true, false>(lds, base, 62, dst, R3, lt);
        scan2_step_load<false, false>(lds, base, 63, dst, R0, lt);
    } else {
        __syncthreads();
#pragma unroll 1
        for (int n = 0; n < 64; ++n) __syncthreads();
    }
}
#undef S2_GLOAD
#undef S2_LSTORE
#undef S2_ULOAD

constexpr int OP_QD = 0, OP_IN = 17408, OP_IMG = 17408 + 9216, OP_PART = 2 * OP_IMG, OP_RSTD = OP_PART + 2048, OP_TILE = OP_RSTD + 256;
DI void opass_load(const Args& a, int unit, u32x4 (&st)[3], bf16x8 (&bs)[4], bf16x8 (&bv)[2], u32x4 (&gg)[2]) {
    const int tid = opaque_tid(), lane = tid & 63, wid = tid >> 6;
    unsigned char* ws = a.ws;
    const int n = unit & 63, h = (unit >> 6) & 3, b = unit >> 8;
    const size_t tok0 = (size_t)b * SEQ + n * 64;
    const unsigned char* ub = ws + WS_R6 + (size_t)unit * DN_UNIT_BYTES;
    st[0] = *(const u32x4*)(ub + 16384 + tid * 16); st[1] = *(const u32x4*)(ub + 16384 + 8192 + tid * 16); st[2] = *(const u32x4*)(ub + 49152 + tid * 16);
    const unsigned char* sb = ws + WS_SB + ((size_t)unit * 8 + wid) * 4096 + lane * 16;
#pragma unroll
    for (int s = 0; s < 4; ++s) bs[s] = *(const bf16x8*)(sb + s * 1024);
    const unsigned char* vb = ub + 57344 + wid * 2048 + lane * 16;
    bv[0] = *(const bf16x8*)vb; bv[1] = *(const bf16x8*)(vb + 1024);
    const bf16_t* pg = (const bf16_t*)(ws + WS_R4) + (tok0 + (tid >> 3)) * 512 + h * 128 + 16 * (tid & 7);
    gg[0] = *(const u32x4*)pg; gg[1] = *(const u32x4*)(pg + 8);
}
DI void opass_stage(LAS unsigned char* img, const u32x4 (&st)[3]) {
    const int tid = opaque_tid();
    *(LAS u32x4*)(img + OP_QD + (tid >> 4) * 272 + (tid & 15) * 16) = st[0];
    *(LAS u32x4*)(img + OP_QD + (32 + (tid >> 4)) * 272 + (tid & 15) * 16) = st[1];
    *(LAS u32x4*)(img + OP_IN + (tid >> 3) * 144 + (tid & 7) * 16) = st[2];
}
DI void opass_compute(const Args& a, LAS unsigned char* lds, const LAS unsigned char* img, int unit, const bf16x8 (&BS)[4], const bf16x8 (&BV)[2], const u32x4 (&gg)[2]) {
    const int tid = opaque_tid(), lane = tid & 63, wid = tid >> 6, fr = lane & 15, fq = lane >> 4;
    unsigned char* ws = a.ws;
    const int n = unit & 63, h = (unit >> 6) & 3, b = unit >> 8;
    const size_t tok0 = (size_t)b * SEQ + n * 64;
    f32x4 Q[4];
    {
        bf16x8 aq[4][4], ai[4][2];
#pragma unroll
        for (int m = 0; m < 4; ++m) {
#pragma unroll
            for (int s = 0; s < 4; ++s) aq[m][s] = *(const LAS bf16x8*)(img + OP_QD + (16 * m + fr) * 272 + 64 * s + 16 * fq);
#pragma unroll
            for (int s = 0; s < 2; ++s) ai[m][s] = *(const LAS bf16x8*)(img + OP_IN + (16 * m + fr) * 144 + 64 * s + 16 * fq);
        }
#pragma unroll
        for (int m = 0; m < 4; ++m) {
            f32x4 q = {0.f, 0.f, 0.f, 0.f};
#pragma unroll
            for (int s = 0; s < 4; ++s) q = mfma16(aq[m][s], BS[s], q);
#pragma unroll
            for (int s = 0; s < 2; ++s) q = mfma16(ai[m][s], BV[s], q);
            Q[m] = q;
        }
    }
    LAS float* part = (LAS float*)(lds + OP_PART);
    LAS float* rstd = (LAS float*)(lds + OP_RSTD);
    LAS unsigned char* tile = lds + OP_TILE;
#pragma unroll
    for (int m = 0; m < 4; ++m)
#pragma unroll
        for (int r = 0; r < 4; ++r) {
            float v = Q[m][r] * Q[m][r];
            v += dppf<0xB1>(v); v += dppf<0x4E>(v); v += dppf<0x141>(v); v += dppf<0x140>(v);
            if (fr == 0) part[wid * 64 + 16 * m + 4 * fq + r] = v;
        }
    __syncthreads();
    if (tid < 64) {
        float sum = 0.f;
#pragma unroll
        for (int w = 0; w < 8; ++w) sum += part[w * 64 + tid];
        rstd[tid] = rsqrtf(sum * (1.0f / 128.0f) + EPS);
    }
    __syncthreads();
    {
        const float nwc = a.in[I_DNNORM][16 * wid + fr];
#pragma unroll
        for (int m = 0; m < 4; ++m) {
            const f32x4 rs4 = *(const LAS f32x4*)(rstd + 16 * m + 4 * fq);
#pragma unroll
            for (int r = 0; r < 4; ++r) *(LAS bf16_t*)(tile + (16 * m + 4 * fq + r) * 272 + 2 * (16 * wid + fr)) = (bf16_t)f2bf(Q[m][r] * rs4[r] * nwc);
        }
    }
    __syncthreads();
    {
        const int token = tid >> 3, g8 = tid & 7;
        const u32x4 y0 = *(const LAS u32x4*)(tile + token * 272 + g8 * 32), y1 = *(const LAS u32x4*)(tile + token * 272 + g8 * 32 + 16);
        const unsigned yw[8] = {y0.x, y0.y, y0.z, y0.w, y1.x, y1.y, y1.z, y1.w}, gw[8] = {gg[0].x, gg[0].y, gg[0].z, gg[0].w, gg[1].x, gg[1].y, gg[1].z, gg[1].w};
        unsigned ow[8];
#pragma unroll
        for (int e = 0; e < 8; ++e) ow[e] = pk2(bflo(yw[e]) * siluf_(bflo(gw[e])), bfhi(yw[e]) * siluf_(bfhi(gw[e])));
        bf16_t* mp = (bf16_t*)(ws + WS_R1) + (tok0 + token) * DM + 512 + h * 128 + 16 * g8;
        *(u32x4*)mp = (u32x4){ow[0], ow[1], ow[2], ow[3]}; *(u32x4*)(mp + 8) = (u32x4){ow[4], ow[5], ow[6], ow[7]};
    }
}
DI void phase_opass(const Args& a, LAS unsigned char* lds, int bid, int G) {
    u32x4 stA[3], stB[3], ggA[2], ggB[2]; bf16x8 bsA[4], bsB[4], bvA[2], bvB[2];
    int u = bid, buf = 0;
    if (u < 1024) opass_load(a, u, stA, bsA, bvA, ggA);
    while (u < 1024) {
        opass_stage(lds + buf * OP_IMG, stA);
        __syncthreads();
        const int un = u + G;
        if (un < 1024) opass_load(a, un, stB, bsB, bvB, ggB);
        opass_compute(a, lds, lds + buf * OP_IMG, u, bsA, bvA, ggA);
#pragma unroll
        for (int i = 0; i < 3; ++i) stA[i] = stB[i];
#pragma unroll
        for (int i = 0; i < 4; ++i) bsA[i] = bsB[i];
        bvA[0] = bvB[0]; bvA[1] = bvB[1]; ggA[0] = ggB[0]; ggA[1] = ggB[1];
        buf ^= 1; u = un;
    }
}

template <int MODE>
DI void phase_tables(const Args& a, int row_lo, int row_hi, int vb, int nvb) {
    const int tid = opaque_tid(), lane = tid & 63, wid = tid >> 6;
    unsigned char* ws = a.ws;
    unsigned char* dn8 = ws + WS_DNT;
    unsigned char* up8 = ws + WS_UPT;
    const float* n2 = a.in[I_N2W];
    f32x4 nw[4];
#pragma unroll
    for (int q = 0; q < 4; ++q) nw[q] = *(const f32x4*)(n2 + 16 * lane + 4 * q) * PEER_SC_D;
    constexpr int NR = MODE == 0 ? 2 : 4;
    for (int e0 = row_lo + vb * 8 + wid; e0 < row_hi; e0 += NR * nvb * 8) {
        f32x4 v[4][4];
#pragma unroll
        for (int it = 0; it < 4; ++it) {
            const int k = MODE == 0 ? (it >> 1) : it, which = MODE == 0 ? (it & 1) : (MODE == 2);
            const int e = e0 + k * nvb * 8, ec = e < row_hi ? e : e0;
#pragma unroll
            for (int q = 0; q < 4; ++q) v[it][q] = ((const f32x4*)((which ? a.in[I_EUP] : a.in[I_EDOWN]) + (size_t)ec * DM + 16 * lane))[q];
        }
#pragma unroll
        for (int it = 0; it < 4; ++it) {
            const int k = MODE == 0 ? (it >> 1) : it, which = MODE == 0 ? (it & 1) : (MODE == 2);
            const int e = e0 + k * nvb * 8;
            u32x4 o;
#pragma unroll
            for (int q = 0; q < 4; ++q) {
                const f32x4 x = which ? v[it][q] * PEER_SC_U : v[it][q] * nw[q];
                unsigned p = __builtin_amdgcn_cvt_pk_fp8_f32(x[0], x[1], 0, false);
                p = __builtin_amdgcn_cvt_pk_fp8_f32(x[2], x[3], p, true);
                o[q] = p;
            }
            if (e < row_hi) *(u32x4*)((which ? up8 : dn8) + (size_t)(lane >> 3) * PEER_SLICE + (size_t)e * 128 + (lane & 7) * 16) = o;
        }
    }
}

DI void ce(float& hi, float& lo) { const float a = hi, b = lo; hi = fmaxf(a, b); lo = fminf(a, b); }
DI void sort16_desc(float (&x)[16]) {
    ce(x[0], x[13]); ce(x[1], x[12]); ce(x[2], x[15]); ce(x[3], x[14]); ce(x[4], x[8]); ce(x[5], x[6]); ce(x[7], x[11]); ce(x[9], x[10]);
    ce(x[0], x[5]); ce(x[1], x[7]); ce(x[2], x[9]); ce(x[3], x[4]); ce(x[6], x[13]); ce(x[8], x[14]); ce(x[10], x[15]); ce(x[11], x[12]);
    ce(x[0], x[1]); ce(x[2], x[3]); ce(x[4], x[5]); ce(x[6], x[8]); ce(x[7], x[9]); ce(x[10], x[11]); ce(x[12], x[13]); ce(x[14], x[15]);
    ce(x[0], x[2]); ce(x[1], x[3]); ce(x[4], x[10]); ce(x[5], x[11]); ce(x[6], x[7]); ce(x[8], x[9]); ce(x[12], x[14]); ce(x[13], x[15]);
    ce(x[1], x[2]); ce(x[3], x[12]); ce(x[4], x[6]); ce(x[5], x[7]); ce(x[8], x[10]); ce(x[9], x[11]); ce(x[13], x[14]);
    ce(x[1], x[4]); ce(x[2], x[6]); ce(x[5], x[8]); ce(x[7], x[10]); ce(x[9], x[13]); ce(x[11], x[14]);
    ce(x[2], x[4]); ce(x[3], x[6]); ce(x[9], x[12]); ce(x[11], x[13]);
    ce(x[3], x[5]); ce(x[6], x[8]); ce(x[7], x[9]); ce(x[10], x[12]);
    ce(x[3], x[4]); ce(x[5], x[6]); ce(x[7], x[8]); ce(x[9], x[10]); ce(x[11], x[12]);
    ce(x[6], x[7]); ce(x[8], x[9]);
}
DI void bmerge16_desc(float (&x)[16]) {
#pragma unroll
    for (int j = 8; j > 0; j >>= 1)
#pragma unroll
        for (int i = 0; i < 16; ++i) { const int l = i ^ j; if (l > i) ce(x[i], x[l]); }
}
DI void merge_top16(float (&x)[16], const float (&y)[16]) {
#pragma unroll
    for (int i = 0; i < 16; ++i) x[i] = fmaxf(x[i], y[15 - i]);
    bmerge16_desc(x);
}
struct CandTab { int i[64]; int j[64]; };
constexpr CandTab make_cand() {
    CandTab t{}; int n = 0;
    for (int i = 0; i < 16; ++i) for (int j = 0; j < 16; ++j) if ((i + 1) * (j + 1) <= 16) { t.i[n] = i; t.j[n] = j; ++n; }
    for (; n < 64; ++n) { t.i[n] = -1; t.j[n] = -1; }
    return t;
}
constexpr CandTab CAND = make_cand();

DI void topk_half(const bf16_t* qrow  , const LAS unsigned char* keys  , int r32, int hh, float (&top)[16]) {
    bf16x8 bq[8];
#pragma unroll
    for (int s = 0; s < 8; ++s) bq[s] = *(const bf16x8*)(qrow + 16 * s + 8 * hh);
    float run[16];
#pragma unroll
    for (int mt = 0; mt < 4; ++mt) {
        f32x16 acc;
#pragma unroll
        for (int e = 0; e < 16; ++e) acc[e] = 0.f;
#pragma unroll
        for (int s = 0; s < 8; ++s) { const bf16x8 A = *(const LAS bf16x8*)(keys + (32 * mt + r32) * 272 + 32 * s + 16 * hh); acc = mfma32(A, bq[s], acc); }
        asm volatile("" ::: "memory");
        float cur[16];
#pragma unroll
        for (int e = 0; e < 16; ++e) {
            const unsigned key = 32 * mt + (e & 3) + 8 * (e >> 2) + 4 * hh;
            cur[e] = __uint_as_float((__float_as_uint(acc[e]) & ~127u) | key);
        }
        sort16_desc(cur);
        if (mt == 0) {
#pragma unroll
            for (int e = 0; e < 16; ++e) run[e] = cur[e];
        } else merge_top16(run, cur);
        asm volatile("" : "+v"(run[0]), "+v"(run[1]), "+v"(run[2]), "+v"(run[3]), "+v"(run[4]), "+v"(run[5]), "+v"(run[6]), "+v"(run[7]));
        asm volatile("" : "+v"(run[8]), "+v"(run[9]), "+v"(run[10]), "+v"(run[11]), "+v"(run[12]), "+v"(run[13]), "+v"(run[14]), "+v"(run[15]));
    }
    float oth[16];
#pragma unroll
    for (int e = 0; e < 16; ++e) oth[e] = __shfl_xor(run[e], 32);
    merge_top16(run, oth);
#pragma unroll
    for (int e = 0; e < 16; ++e) top[e] = run[e];
}

DI void phase_topk(const Args& a, LAS unsigned char* lds, int bid, int G) {
    const int wid = threadIdx.x >> 6;
    unsigned char* ws = a.ws;
    const bf16_t* qry = (const bf16_t*)(ws + WS_QRY);
    const bf16_t* keys = (const bf16_t*)(ws + WS_KEYS);
    const float* rstd2 = (const float*)(ws + WS_RSTD2);
    int* idx_out = (int*)(ws + WS_IDX);
    float* gate_out = (float*)(ws + WS_GATES);
    LAS unsigned* lw = (LAS unsigned*)(lds + 2 * 128 * 272 + wid * 8192);
    __syncthreads();
    for (int c = threadIdx.x; c < 2 * 128 * 16; c += NTHR) {
        const int row = c >> 4, ch = c & 15;
        *(LAS u32x4*)(lds + row * 272 + ch * 16) = *(const u32x4*)(keys + row * 128 + ch * 8);
    }
    __syncthreads();
    const bool local_map = (G == 256);
    for (int it_ = 0; it_ < (local_map ? 2 : (512 * 8 - 1 - (bid * 8 + wid)) / (G * 8) + 1); ++it_) {
        const int item = local_map ? ((2 * bid + it_) * 8 + wid) : (bid * 8 + wid + it_ * G * 8);
        if (item >= 512 * 8) break;
        int lane = threadIdx.x & 63;
        asm volatile("" : "+v"(lane));
        const int r32 = lane & 31, hh = lane >> 5;
        const int tg = item >> 3, h = item & 7, tok = tg * 32 + r32;
        float v1[16], v2[16];
        topk_half(qry + (size_t)tok * 2048 + h * 256, lds, r32, hh, v1);
        topk_half(qry + (size_t)tok * 2048 + h * 256 + 128, lds + 128 * 272, r32, hh, v2);
#pragma unroll
        for (int m = 0; m < 16; ++m) { lw[m * 64 + lane] = __float_as_uint(v1[m]); lw[(16 + m) * 64 + lane] = __float_as_uint(v2[m]); }
        float ca[16], cb[16];
#pragma unroll
        for (int m = 0; m < 32; ++m) {
            constexpr float NEG = -3.0e38f;
            float s0 = NEG, s1 = NEG;
            const int i0 = CAND.i[m], j0 = CAND.j[m], i1 = CAND.i[32 + m], j1 = CAND.j[32 + m];
            if (i0 >= 0) s0 = __uint_as_float((__float_as_uint(v1[i0 >= 0 ? i0 : 0] + v2[j0 >= 0 ? j0 : 0]) & ~255u) | (unsigned)(i0 * 16 + j0));
            if (i1 >= 0) s1 = __uint_as_float((__float_as_uint(v1[i1 >= 0 ? i1 : 0] + v2[j1 >= 0 ? j1 : 0]) & ~255u) | (unsigned)(i1 * 16 + j1));
            const float s = hh ? s1 : s0;
            if (m < 16) ca[m] = s; else cb[m - 16] = s;
        }
        sort16_desc(ca); sort16_desc(cb); merge_top16(ca, cb);
#pragma unroll
        for (int e = 0; e < 16; ++e) cb[e] = __shfl_xor(ca[e], 32);
        merge_top16(ca, cb);
        const float rs = rsqrtf(rstd2[tok] * (1.0f / DM) + EPS);
        float ex[16], sum = 0.f;
#pragma unroll
        for (int e = 0; e < 16; ++e) { ex[e] = __expf((ca[e] - ca[0]) * rs); sum += ex[e]; }
        const float inv = 1.0f / sum;
        int idx[16];
#pragma unroll
        for (int e = 0; e < 16; ++e) {
            const unsigned code = __float_as_uint(ca[e]) & 255u;
            const unsigned i1 = lw[(code >> 4) * 64 + lane] & 127u, i2 = lw[(16 + (code & 15)) * 64 + lane] & 127u;
            idx[e] = (int)(i1 * 128 + i2);
        }
        if (hh == 0) {
#pragma unroll
            for (int k = 0; k < 4; ++k) *(i32x4*)(idx_out + (size_t)tok * 128 + h * 16 + 4 * k) = (i32x4){idx[4 * k], idx[4 * k + 1], idx[4 * k + 2], idx[4 * k + 3]};
        } else {
#pragma unroll
            for (int k = 0; k < 4; ++k) *(f32x4*)(gate_out + (size_t)tok * 128 + h * 16 + 4 * k) = (f32x4){ex[4 * k] * inv, ex[4 * k + 1] * inv, ex[4 * k + 2] * inv, ex[4 * k + 3] * inv};
        }
    }
}

constexpr int PG_IROW = 264;
constexpr int PG_WROW = 528;
constexpr int PG_WOFF = 64 * PG_IROW;
DI f32x2 cvt2(unsigned w, bool hi) { return hi ? __builtin_amdgcn_cvt_pk_f32_fp8(w, true) : __builtin_amdgcn_cvt_pk_f32_fp8(w, false); }
DI float dot16_fp8(const f32x2 (&h)[8], const u32x4 v) {
    f32x2 acc = h[0] * cvt2(v.x, false);
    acc += h[1] * cvt2(v.x, true);
    acc += h[2] * cvt2(v.y, false);
    acc += h[3] * cvt2(v.y, true);
    acc += h[4] * cvt2(v.z, false);
    acc += h[5] * cvt2(v.z, true);
    acc += h[6] * cvt2(v.w, false);
    acc += h[7] * cvt2(v.w, true);
    return acc[0] + acc[1];
}
DI void axpy16_fp8(f32x2 (&acc)[8], const float w, const u32x4 v) {
    const f32x2 w2 = {w, w};
    acc[0] += w2 * cvt2(v.x, false); acc[1] += w2 * cvt2(v.x, true);
    acc[2] += w2 * cvt2(v.y, false); acc[3] += w2 * cvt2(v.y, true);
    acc[4] += w2 * cvt2(v.z, false); acc[5] += w2 * cvt2(v.z, true);
    acc[6] += w2 * cvt2(v.w, false); acc[7] += w2 * cvt2(v.w, true);
}
template <int CTRL> DI float dpp_f(float v) { return __int_as_float(__builtin_amdgcn_update_dpp(0, __float_as_int(v), CTRL, 0xf, 0xf, true)); }
DI float sum8(float v) {
    v += dpp_f<0xB1>(v);
    v += dpp_f<0x4E>(v);
    v += dpp_f<0x141>(v);
    return v;
}
#define PG_LOAD8(dst, base, iw) do { _Pragma("unroll") for (int m_ = 0; m_ < 8; ++m_) { \
        const unsigned e_ = ((m_ & 1) ? ((iw)[m_ >> 1] >> 16) : ((iw)[m_ >> 1] & 0xffffu)); \
        dst[m_] = __builtin_amdgcn_raw_buffer_load_b128(base, e_ * 128u + joff, soff, 0); } } while (0)
DI void phase_gather(const Args& a, LAS unsigned char* lds, int bid, int G) {
    const int wid = threadIdx.x >> 6;
    unsigned char* ws = a.ws;
    const bf16_t* h2b = (const bf16_t*)(ws + WS_H2B);
    const __amdgpu_buffer_rsrc_t rs_dn = __builtin_amdgcn_make_buffer_rsrc((void*)(ws + WS_DNT), 0, 8 * (int)PEER_SLICE, 0x00020000);
    const __amdgpu_buffer_rsrc_t rs_up = __builtin_amdgcn_make_buffer_rsrc((void*)(ws + WS_UPT), 0, 8 * (int)PEER_SLICE, 0x00020000);
    const int* idxp = (const int*)(ws + WS_IDX);
    const float* gatep = (const float*)(ws + WS_GATES);
    const float* rstd2 = (const float*)(ws + WS_RSTD2);
    for (int tile = bid; tile < 256; tile += G) {
        int lane = threadIdx.x & 63;
        asm volatile("" : "+v"(lane));
        const int g = lane >> 3, j = lane & 7, tl = wid * 8 + g, tok = tile * 64 + tl;
        __syncthreads();
        for (int e = threadIdx.x; e < 2048; e += NTHR) {
            const i32x4 v = *(const i32x4*)(idxp + (size_t)tile * 8192 + 4 * e);
            u32x2 w; w.x = (unsigned)v[0] | ((unsigned)v[1] << 16); w.y = (unsigned)v[2] | ((unsigned)v[3] << 16);
            *(LAS u32x2*)(lds + (e >> 5) * PG_IROW + (e & 31) * 8) = w;
        }
        __syncthreads();
        const LAS unsigned char* irow = lds + tl * PG_IROW;
        LAS unsigned char* wrow = lds + PG_WOFF + tl * PG_WROW;
#ifndef GD_REPS
#define GD_REPS 1
#endif
#pragma unroll 1
        for (int hp_ = 0; hp_ < 2 * GD_REPS; ++hp_) { const int hp = hp_ & 1;
            float p[64];
#pragma unroll
            for (int k = 0; k < 64; ++k) p[k] = 0.f;
            const LAS unsigned char* ir = irow + hp * 128;
#pragma unroll 1
            for (int c = 0; c < 8; ++c) {
                f32x2 hf[8];
                {
                    const u32x4* hp_ = (const u32x4*)(h2b + (size_t)tok * DM + 128 * c + 16 * j);
                    const u32x4 h0 = hp_[0], h1 = hp_[1];
                    hf[0] = (f32x2){bflo(h0.x), bfhi(h0.x)}; hf[1] = (f32x2){bflo(h0.y), bfhi(h0.y)}; hf[2] = (f32x2){bflo(h0.z), bfhi(h0.z)}; hf[3] = (f32x2){bflo(h0.w), bfhi(h0.w)};
                    hf[4] = (f32x2){bflo(h1.x), bfhi(h1.x)}; hf[5] = (f32x2){bflo(h1.y), bfhi(h1.y)}; hf[6] = (f32x2){bflo(h1.z), bfhi(h1.z)}; hf[7] = (f32x2){bflo(h1.w), bfhi(h1.w)};
                }
                const __amdgpu_buffer_rsrc_t sb = rs_dn; const unsigned joff = j * 16; const int soff = c * (int)PEER_SLICE;
                u32x4 va[8], vb[8];
                { const u32x4 iw = *(const LAS u32x4*)(ir); PG_LOAD8(va, sb, iw); }
#pragma unroll
                for (int bt = 0; bt < 8; bt += 2) {
                    { const u32x4 iw = *(const LAS u32x4*)(ir + (bt + 1) * 16); PG_LOAD8(vb, sb, iw); }
#pragma unroll
                    for (int m = 0; m < 8; ++m) p[8 * bt + m] += dot16_fp8(hf, va[m]);
                    if (bt + 2 < 8) { const u32x4 iw = *(const LAS u32x4*)(ir + (bt + 2) * 16); PG_LOAD8(va, sb, iw); }
#pragma unroll
                    for (int m = 0; m < 8; ++m) p[8 * (bt + 1) + m] += dot16_fp8(hf, vb[m]);
                }
            }
            const float rs = rsqrtf(rstd2[tok] * (1.0f / DM) + EPS) * (1.0f / PEER_SC_D);
#pragma unroll
            for (int bt = 0; bt < 8; ++bt) {
                float mine = 0.f;
#pragma unroll
                for (int m = 0; m < 8; ++m) { const float s_ = sum8(p[8 * bt + m]); mine = (j == m) ? s_ : mine; }
                const float x = mine * rs;
                const float gt = gatep[(size_t)tok * 128 + 64 * hp + 8 * bt + j];
                const float w = gt * 0.5f * x * (1.0f + erff(x * 0.70710678118654752f)) * (1.0f / PEER_SC_U);
                *(LAS float*)(wrow + (64 * hp + 8 * bt + j) * 4) = w;
            }
        }
        int lane2 = threadIdx.x & 63;
        asm volatile("" : "+v"(lane2));
        const int g2 = lane2 >> 3, j2 = lane2 & 7, tl2 = wid * 8 + g2, tok2 = tile * 64 + tl2;
        const LAS unsigned char* irow2 = lds + tl2 * PG_IROW;
        const LAS unsigned char* wrow2 = lds + PG_WOFF + tl2 * PG_WROW;
#pragma unroll 1
        for (int c = 0; c < 8; ++c) {
            f32x2 acc[8];
#pragma unroll
            for (int i = 0; i < 8; ++i) acc[i] = (f32x2){0.f, 0.f};
            const __amdgpu_buffer_rsrc_t sb = rs_up; const unsigned joff = j2 * 16; const int soff = c * (int)PEER_SLICE;
            u32x4 va[8], vb[8];
            { const u32x4 iw = *(const LAS u32x4*)(irow2); PG_LOAD8(va, sb, iw); }
#pragma unroll 1
            for (int bt = 0; bt < 16; bt += 2) {
                { const u32x4 iw = *(const LAS u32x4*)(irow2 + (bt + 1) * 16); PG_LOAD8(vb, sb, iw); }
                { const f32x4 w0 = *(const LAS f32x4*)(wrow2 + bt * 32), w1 = *(const LAS f32x4*)(wrow2 + bt * 32 + 16);
#pragma unroll
                  for (int m = 0; m < 4; ++m) { axpy16_fp8(acc, w0[m], va[m]); }
#pragma unroll
                  for (int m = 0; m < 4; ++m) { axpy16_fp8(acc, w1[m], va[4 + m]); } }
                if (bt + 2 < 16) { const u32x4 iw = *(const LAS u32x4*)(irow2 + (bt + 2) * 16); PG_LOAD8(va, sb, iw); }
                { const f32x4 w0 = *(const LAS f32x4*)(wrow2 + (bt + 1) * 32), w1 = *(const LAS f32x4*)(wrow2 + (bt + 1) * 32 + 16);
#pragma unroll
                  for (int m = 0; m < 4; ++m) { axpy16_fp8(acc, w0[m], vb[m]); }
#pragma unroll
                  for (int m = 0; m < 4; ++m) { axpy16_fp8(acc, w1[m], vb[4 + m]); } }
            }
            const u32x4* xp = (const u32x4*)(h2b + (size_t)tok2 * DM + 128 * c + 16 * j2);
            const u32x4 x0 = xp[0], x1v = xp[1];
            f32x4* op = (f32x4*)(a.out + (size_t)tok2 * DM + 128 * c + 16 * j2);
            op[0] = (f32x4){bflo(x0.x) + acc[0][0], bfhi(x0.x) + acc[0][1], bflo(x0.y) + acc[1][0], bfhi(x0.y) + acc[1][1]};
            op[1] = (f32x4){bflo(x0.z) + acc[2][0], bfhi(x0.z) + acc[2][1], bflo(x0.w) + acc[3][0], bfhi(x0.w) + acc[3][1]};
            op[2] = (f32x4){bflo(x1v.x) + acc[4][0], bfhi(x1v.x) + acc[4][1], bflo(x1v.y) + acc[5][0], bfhi(x1v.y) + acc[5][1]};
            op[3] = (f32x4){bflo(x1v.z) + acc[6][0], bfhi(x1v.z) + acc[6][1], bflo(x1v.w) + acc[7][0], bfhi(x1v.w) + acc[7][1]};
        }
    }
}

constexpr int N_PHASES = 9;
__global__ void __launch_bounds__(NTHR, 2) fwd(Args a) {
    extern __shared__ __attribute__((aligned(16))) unsigned char lds_raw[];
    LAS unsigned char* lds = (LAS unsigned char*)lds_raw;
    const int bid = blockIdx.x, G = gridDim.x;
    unsigned char* ws = a.ws;
    const int lo = a.ph_lo, hi = a.ph_hi;
    XcdBarrier xb;
    if (hi - lo > 1) {
        LAS unsigned* st = (LAS unsigned*)(lds + LDS_BYTES - 16);
        if (threadIdx.x == 0) { st[0] = 0u; st[1] = 0u; }
        __syncthreads();
        xb = xcd_barrier_post((unsigned*)(ws + WS_BAR), (volatile LAS unsigned*)st);
    }
#ifdef ONLY_PHASE
#define IN(k) ((k) == ONLY_PHASE)
#else
#define IN(k) (lo <= (k) && (k) < hi)
#endif
#define SEAM(k) do { if (IN(k) && IN((k) + 1)) xcd_barrier(xb); } while (0)
#ifndef REPEAT_MASK
#define REPEAT_MASK 0
#endif
#define REPS(k) (((REPEAT_MASK >> (k)) & 1) ? 2 : 1)
    for (int rep = 0; rep < REPS(0); ++rep) { if (IN(0)) { phase_prep(a, lds, bid, G);
#ifdef P0_TWICE
        __syncthreads(); phase_prep(a, lds, bid, G);
#endif
    }
    SEAM(0); }
    for (int rep = 0; rep < REPS(1); ++rep) { if (IN(1)) { pg8::EpiProj e{(bf16_t*)(ws + WS_R2), (bf16_t*)(ws + WS_R3), (bf16_t*)(ws + WS_R4), (const float*)(ws + WS_RSTD1)};
                 pg8::StaticOrder so; so.init(NTOK, NPROJ, G, bid);
                 pg8::gemm_phase<pg8::EpiProj, pg8::StaticOrder, true, true>(lds, pg8::Gemm{(const bf16_t*)(ws + WS_R1), (const bf16_t*)(ws + WS_WINT), NTOK, NPROJ, DM}, so, e);
                 if (UP_EARLY > 0 && G == 256 && bid >= 192) phase_tables<2>(a, 0, UP_EARLY, bid - 192, 64); }
    SEAM(1); }
    for (int rep = 0; rep < REPS(2); ++rep) { if (IN(2)) {
#ifndef QK_REPS
#define QK_REPS 1
#endif
#ifndef DP_REPS
#define DP_REPS 1
#endif
        for (int rr = 0; rr < QK_REPS; ++rr) phase_qknorm(a, bid, G);
        for (int rr = 0; rr < DP_REPS; ++rr) phase_dnprep(a, lds, bid, G); }
    SEAM(2); }
    for (int rep = 0; rep < REPS(3); ++rep) { if (IN(3)) {
#ifndef SCAN_REPS
#define SCAN_REPS 1
#endif
#ifndef ATTN_REPS
#define ATTN_REPS 1
#endif
        if (G >= 128) {
            for (int rr = 0; rr < SCAN_REPS; ++rr) if (bid < S2_NBLK) { const int k = bid >> 3; scan2_unit(a, lds, (k % S2_PARTS) * 16 + (bid & 7) + 8 * (k / S2_PARTS)); }
            for (int rr = 0; rr < ATTN_REPS; ++rr) if (bid >= S2_NBLK) { for (int u = bid - S2_NBLK; u < 512; u += G - S2_NBLK) attn_unit(a, lds, u); }
            const int up_lo = G == 256 ? UP_EARLY : 0;
            if (bid >= S2_NBLK) { if (up_lo > 0) phase_tables<1>(a, 0, up_lo, bid - S2_NBLK, G - S2_NBLK);
                                  phase_tables<0>(a, up_lo, TAB_SPLIT, bid - S2_NBLK, G - S2_NBLK); }
            else if (TAB_SPLIT < 16384) phase_tables<0>(a, TAB_SPLIT, 16384, bid, S2_NBLK);
        } else {
            for (int u = bid; u < S2_NBLK; u += G) scan2_unit(a, lds, u);
            for (int u = bid; u < 512; u += G) attn_unit(a, lds, u);
            phase_tables<0>(a, 0, 16384, bid, G);
        }
    }
    SEAM(3); }
    for (int rep = 0; rep < REPS(4); ++rep) { if (IN(4)) {
        phase_opass(a, lds, bid, G);
    }
    SEAM(4); }
    for (int rep = 0; rep < REPS(5); ++rep) { if (IN(5)) { pg8::EpiOut e{a.in[I_X], a.out, (bf16_t*)(ws + WS_H2B), (float*)(ws + WS_RSTD2)};
                 pg8::StaticOrder so; so.init(NTOK, DM, G, bid);
                 pg8::gemm_phase<pg8::EpiOut, pg8::StaticOrder, true, true>(lds, pg8::Gemm{(const bf16_t*)(ws + WS_R1), (const bf16_t*)(ws + WS_WOUTT), NTOK, DM, DM}, so, e); }
    SEAM(5); }
    for (int rep = 0; rep < REPS(6); ++rep) { if (IN(6)) {
                 __syncthreads();
                 pg8::EpiQry e{(bf16_t*)(ws + WS_QRY)};
                 pg8::StaticOrder so; so.init(NTOK, 2048, G, bid);
                 pg8::gemm_phase<pg8::EpiQry, pg8::StaticOrder, true, true>(lds, pg8::Gemm{(const bf16_t*)(ws + WS_H2B), (const bf16_t*)(ws + WS_WQT), NTOK, 2048, DM}, so, e); }
    SEAM(6); }
    for (int rep = 0; rep < REPS(7); ++rep) { if (IN(7)) phase_topk(a, lds, bid, G);
    if (G == 256 && IN(7) && IN(8)) { asm volatile("s_waitcnt vmcnt(0)" ::: "memory"); __syncthreads(); }
    else SEAM(7); }
    if (IN(8)) phase_gather(a, lds, bid, G);
}

extern "C" void kernel_launch(void* const* d_in, const int* in_sizes, int n_in, void* d_out, int out_size, void* d_ws, size_t ws_size, hipStream_t stream) {
    static int grid = 0;
    if (grid == 0) {
        if (n_in != 17 || out_size != NTOK * DM || ws_size < WS_END) { fprintf(stderr, "kernel_launch: unexpected shapes (n_in %d out %d ws %zu)\n", n_in, out_size, ws_size); grid = -1; return; }
        int dev = 0, cus = 0, per_cu = 0;
        if (hipGetDevice(&dev) != hipSuccess || hipDeviceGetAttribute(&cus, hipDeviceAttributeMultiprocessorCount, dev) != hipSuccess) { grid = -1; return; }
        if (hipFuncSetAttribute((const void*)fwd, hipFuncAttributeMaxDynamicSharedMemorySize, LDS_BYTES) != hipSuccess) { fprintf(stderr, "kernel_launch: hipFuncSetAttribute failed\n"); grid = -1; return; }
        if (hipOccupancyMaxActiveBlocksPerMultiprocessor(&per_cu, (const void*)fwd, NTHR, LDS_BYTES) != hipSuccess || per_cu < 1) { fprintf(stderr, "kernel_launch: occupancy query says %d\n", per_cu); }
        (void)hipGetLastError();
        grid = cus;
    }
    if (grid < 0) return;
    Args a{};
    for (int i = 0; i < 17; ++i) a.in[i] = (const float*)d_in[i];
    a.out = (float*)d_out; a.ws = (unsigned char*)d_ws;
#if N_LAUNCH_PER_PHASE
    for (int p = 0; p < N_PHASES; ++p) { a.ph_lo = p; a.ph_hi = p + 1; hipLaunchKernelGGL(fwd, dim3(grid), dim3(NTHR), LDS_BYTES, stream, a); }
#else
    (void)hipMemsetAsync((unsigned char*)d_ws + WS_BAR, 0, XCD_BAR_WORDS * 4, stream);
    a.ph_lo = 0; a.ph_hi = N_PHASES;
    hipLaunchKernelGGL(fwd, dim3(grid), dim3(NTHR), LDS_BYTES, stream, a);
#endif
}
```

```cpp
#include <hip/hip_runtime.h>
#include <stdint.h>
#include <stdio.h>

#ifndef N_LAUNCH_PER_PHASE
#define N_LAUNCH_PER_PHASE 0
#endif

#define DI __device__ __forceinline__
#define LAS __attribute__((address_space(3)))
typedef unsigned short bf16_t;
typedef short bf16x8 __attribute__((ext_vector_type(8)));
typedef short bf16x4 __attribute__((ext_vector_type(4)));
typedef float f32x2 __attribute__((ext_vector_type(2)));
typedef float f32x4 __attribute__((ext_vector_type(4)));
typedef float f32x16 __attribute__((ext_vector_type(16)));
typedef unsigned u32x2 __attribute__((ext_vector_type(2)));
typedef unsigned u32x4 __attribute__((ext_vector_type(4)));
typedef int i32x4 __attribute__((ext_vector_type(4)));

constexpr int NTOK = 16384, DM = 1024, SEQ = 4096;
constexpr int INW = 2824, NPROJ = 2816;
constexpr int NTHR = 512;
constexpr float EPS = 1e-6f;

constexpr size_t MiB = 1u << 20;
constexpr size_t WS_BAR = 0;
constexpr size_t WS_KEYS = 128 * 1024;
constexpr size_t WS_ROPE = 256 * 1024;
constexpr size_t WS_RSTD1 = 512 * 1024;
constexpr size_t WS_RSTD2 = 576 * 1024;
constexpr size_t WS_GL = 640 * 1024;
constexpr size_t WS_WINT = 2 * MiB;
constexpr size_t WS_WOUTT = 8 * MiB;
constexpr size_t WS_WQT = 10 * MiB;
constexpr size_t WS_GATE = 14 * MiB;
constexpr size_t WS_R1 = 16 * MiB;
constexpr size_t WS_R2 = 48 * MiB;
constexpr size_t WS_R3 = 72 * MiB;
constexpr size_t WS_R4 = 120 * MiB;
constexpr size_t WS_R5 = 136 * MiB;
constexpr size_t WS_R6 = 156 * MiB;
constexpr size_t WS_H2B = 188 * MiB;
constexpr size_t WS_DNT = 104 * MiB;
constexpr size_t WS_UPT = 228 * MiB;
constexpr size_t WS_QRY = 120 * MiB;
constexpr size_t WS_IDX = 48 * MiB;
constexpr size_t WS_GATES = 56 * MiB;
constexpr size_t WS_END = 244 * MiB;
constexpr int DN_UNIT_BYTES = 73728;
constexpr int LDS_BYTES = 144 * 1024;
constexpr float PEER_SC_D = 256.0f, PEER_SC_U = 64.0f;
constexpr size_t PEER_SLICE = 16384 * 128;

DI unsigned f2bf(float f) { unsigned u = __float_as_uint(f); return (u + 0x7fffu + ((u >> 16) & 1u)) >> 16; }
typedef __bf16 bf16x2_t __attribute__((ext_vector_type(2)));
DI unsigned pk2(float lo, float hi) { const f32x2 v = {lo, hi}; return __builtin_bit_cast(unsigned, __builtin_convertvector(v, bf16x2_t)); }
DI float bflo(unsigned w) { return __uint_as_float(w << 16); }
DI float bfhi(unsigned w) { return __uint_as_float(w & 0xffff0000u); }
DI float bf2f(bf16_t h) { return __uint_as_float(((unsigned)h) << 16); }
DI float wave_sum(float v) {
#pragma unroll
    for (int o = 32; o > 0; o >>= 1) v += __shfl_xor(v, o);
    return v;
}
template <int CTRL> DI float dppf(float v) { return __int_as_float(__builtin_amdgcn_update_dpp(0, __float_as_int(v), CTRL, 0xf, 0xf, true)); }
DI float wave_sum_dpp(float v) {
    v += dppf<0xB1>(v);
    v += dppf<0x4E>(v);
    v += dppf<0x141>(v);
    v += dppf<0x140>(v);
    const int iv = __float_as_int(v);
    return (__int_as_float(__builtin_amdgcn_readlane(iv, 0)) + __int_as_float(__builtin_amdgcn_readlane(iv, 16))) + (__int_as_float(__builtin_amdgcn_readlane(iv, 32)) + __int_as_float(__builtin_amdgcn_readlane(iv, 48)));
}
DI f32x4 mfma16(bf16x8 a, bf16x8 b, f32x4 c) { return __builtin_amdgcn_mfma_f32_16x16x32_bf16(a, b, c, 0, 0, 0); }
DI f32x16 mfma32(bf16x8 a, bf16x8 b, f32x16 c) { return __builtin_amdgcn_mfma_f32_32x32x16_bf16(a, b, c, 0, 0, 0); }
DI bf16x8 pack8(f32x4 a, f32x4 b) {
    u32x4 p; p.x = pk2(a[0], a[1]); p.y = pk2(a[2], a[3]); p.z = pk2(b[0], b[1]); p.w = pk2(b[2], b[3]);
    return __builtin_bit_cast(bf16x8, p);
}
DI bf16x8 cat8(u32x2 a, u32x2 b) { u32x4 p; p.x = a.x; p.y = a.y; p.z = b.x; p.w = b.y; return __builtin_bit_cast(bf16x8, p); }
DI int opaque_tid() { int t = threadIdx.x; asm volatile("" : "+v"(t)); return t; }
DI __amdgpu_buffer_rsrc_t wt_rsrc(const void* base) { return __builtin_amdgcn_make_buffer_rsrc((void*)base, 0, 0x7fffffff, 0x00020000); }
DI void wt_store16(__amdgpu_buffer_rsrc_t r, unsigned byte_off, u32x4 v) { __builtin_amdgcn_raw_buffer_store_b128(v, r, byte_off, 0, 16); }
DI float sigmoidf_(float x) { return __builtin_amdgcn_rcpf(1.0f + __expf(-x)); }
DI float siluf_(float x) { return x * __builtin_amdgcn_rcpf(1.0f + __expf(-x)); }

#define XB_TMO      128
#define XB_XCNT(j)  (256  + 64 * (j))
#define XB_XSUB(j)  (1280 + 64 * (j))
#define XB_XGEN(j)  (2304 + 64 * (j))
#define XB_TOP      3328
#define XB_TOPGEN   3392
#define XCD_BAR_WORDS 3456
#define XB_SPIN_CAP (1u << 22)
DI unsigned xb_ld(unsigned* p)              { return __hip_atomic_load(p, __ATOMIC_RELAXED, __HIP_MEMORY_SCOPE_AGENT); }
DI unsigned xb_add(unsigned* p, unsigned v) { return __hip_atomic_fetch_add(p, v, __ATOMIC_RELAXED, __HIP_MEMORY_SCOPE_AGENT); }
DI unsigned xb_xcc_id() { return (unsigned)__builtin_amdgcn_s_getreg((3 << 11) | 20) & 0xFu; }
#define XB_SPIN(cond, bar) do { unsigned _sp = 0; while (cond) { if (_sp < 64u) __builtin_amdgcn_s_sleep(2); else __builtin_amdgcn_s_sleep(24); \
    if ((++_sp & 255u) == 0u) { if (xb_ld(&(bar)[XB_TMO])) break; if (_sp > XB_SPIN_CAP) { atomicAdd(&(bar)[XB_TMO], 1u); break; } } } } while (0)
struct XcdBarrier { unsigned* bar; unsigned x; volatile LAS unsigned* st; };
DI XcdBarrier xcd_barrier_post(unsigned* bar, volatile LAS unsigned* st) {
    XcdBarrier b; b.bar = bar; b.x = xb_xcc_id(); b.st = st;
    if (threadIdx.x == 0) (void)xb_add(&bar[XB_XCNT(b.x)], 1u);
    return b;
}
DI void xcd_barrier_complete(unsigned* bar, unsigned x, unsigned& nloc, unsigned& nx) {
    const unsigned G = gridDim.x * gridDim.y * gridDim.z;
    unsigned sum, cnt, mine, sp = 0u;
    for (;;) {
        sum = 0u; cnt = 0u; mine = 0u;
#pragma unroll
        for (unsigned j = 0; j < 16; ++j) { const unsigned c = xb_ld(&bar[XB_XCNT(j)]); sum += c; cnt += (c > 0u) ? 1u : 0u; mine = (j == x) ? c : mine; }
        if (sum == G) break;
        __builtin_amdgcn_s_sleep(1);
        if ((++sp & 255u) == 0u) { if (xb_ld(&bar[XB_TMO])) break; if (sp > XB_SPIN_CAP) { atomicAdd(&bar[XB_TMO], 1u); break; } }
    }
    nloc = mine > 0u ? mine : 1u; nx = cnt > 0u ? cnt : 1u;
}
DI void xcd_barrier(const XcdBarrier& b) {
    asm volatile("s_waitcnt vmcnt(0)" ::: "memory");
    __syncthreads();
    if (threadIdx.x == 0) {
        unsigned* bar = b.bar;
        __builtin_amdgcn_s_waitcnt(0);
        unsigned nloc = b.st[0], nx = b.st[1];
        if (nloc == 0u) { xcd_barrier_complete(bar, b.x, nloc, nx); b.st[0] = nloc; b.st[1] = nx; }
        const unsigned old = xb_add(&bar[XB_XSUB(b.x)], 1u);
        const unsigned gen = old / nloc;
        if (old + 1u == (gen + 1u) * nloc) {
            __builtin_amdgcn_fence(__ATOMIC_RELEASE, "agent");
            asm volatile("s_waitcnt vmcnt(0)" ::: "memory");
            const unsigned og = xb_add(&bar[XB_TOP], 1u);
            const unsigned tg = og / nx;
            if (og + 1u == (tg + 1u) * nx) xb_add(&bar[XB_TOPGEN], 1u);
            else XB_SPIN(xb_ld(&bar[XB_TOPGEN]) == tg, bar);
            __builtin_amdgcn_fence(__ATOMIC_ACQUIRE, "agent");
            xb_add(&bar[XB_XGEN(b.x)], 1u);
            asm volatile("s_waitcnt vmcnt(0)" ::: "memory");
        } else {
            XB_SPIN(xb_ld(&bar[XB_XGEN(b.x)]) == gen, bar);
            __builtin_amdgcn_fence(__ATOMIC_ACQUIRE, "agent");
            asm volatile("s_waitcnt vmcnt(0)" ::: "memory");
        }
    }
    __syncthreads();
}

DI void group_sync(unsigned* cnt, unsigned n, unsigned* bar) {
    asm volatile("s_waitcnt vmcnt(0)" ::: "memory");
    __syncthreads();
    if (threadIdx.x == 0) {
        __builtin_amdgcn_fence(__ATOMIC_RELEASE, "agent");
        asm volatile("s_waitcnt vmcnt(0)" ::: "memory");
        (void)xb_add(cnt, 1u);
        XB_SPIN(xb_ld(cnt) < n, bar);
        __builtin_amdgcn_fence(__ATOMIC_ACQUIRE, "agent");
        asm volatile("s_waitcnt vmcnt(0)" ::: "memory");
    }
    __syncthreads();
}
#define GS_WORD0 4096
#define GS_WORDS (GS_WORD0 + 2 * 64 * 32)

struct Args { const float* in[17]; float* out; unsigned char* ws; int ph_lo, ph_hi; };
enum { I_X = 0, I_N1W, I_WIN, I_QNW, I_KNW, I_SINK, I_CONVW, I_ALOG, I_DTB, I_DNNORM, I_WOUT, I_N2W, I_WQ, I_SK1, I_SK2, I_EDOWN, I_EUP };

DI void p0_transpose_item(const float* W, int ldw, const float* scale, bf16_t* WT, int kt, int nt, LAS float* tile, int lane) {
    float v[64];
    const float* src = W + (size_t)(kt * 64) * ldw + nt * 64 + lane;
#pragma unroll
    for (int r = 0; r < 64; ++r) v[r] = src[(size_t)r * ldw];
    if (scale) {
#pragma unroll
        for (int r = 0; r < 64; ++r) v[r] *= scale[kt * 64 + r];
    }
#pragma unroll
    for (int r = 0; r < 64; ++r) tile[r * 65 + lane] = v[r];
    const int kc = (lane & 7) * 8;
#pragma unroll
    for (int it = 0; it < 8; ++it) {
        const int n = (lane >> 3) + 8 * it;
        u32x4 w;
        w.x = pk2(tile[(kc + 0) * 65 + n], tile[(kc + 1) * 65 + n]);
        w.y = pk2(tile[(kc + 2) * 65 + n], tile[(kc + 3) * 65 + n]);
        w.z = pk2(tile[(kc + 4) * 65 + n], tile[(kc + 5) * 65 + n]);
        w.w = pk2(tile[(kc + 6) * 65 + n], tile[(kc + 7) * 65 + n]);
        *(u32x4*)(WT + (size_t)(nt * 64 + n) * 1024 + kt * 64 + kc) = w;
    }
}

DI void sincos_d(double a, double& s, double& c) {
    const double TWO_OVER_PI = 0.63661977236758134308, PIO2_HI = 1.57079632679489655800e+00, PIO2_LO = 6.12323399573676603587e-17;
    const double q = __builtin_rint(a * TWO_OVER_PI);
    double r = (a - q * PIO2_HI) - q * PIO2_LO;
    const int qi = (int)q & 3;
    const double r2 = r * r;
    double sp = r * (1.0 + r2 * (-1.0 / 6 + r2 * (1.0 / 120 + r2 * (-1.0 / 5040 + r2 * (1.0 / 362880 + r2 * (-1.0 / 39916800 + r2 * (1.0 / 6227020800.0)))))));
    double cp = 1.0 + r2 * (-0.5 + r2 * (1.0 / 24 + r2 * (-1.0 / 720 + r2 * (1.0 / 40320 + r2 * (-1.0 / 3628800 + r2 * (1.0 / 479001600.0 + r2 * (-1.0 / 87178291200.0)))))));
    double ss = (qi & 1) ? cp : sp, cc = (qi & 1) ? sp : cp;
    if (qi == 1) { cc = -cc; } else if (qi == 2) { ss = -ss; cc = -cc; } else if (qi == 3) { ss = -ss; }
    s = ss; c = cc;
}

DI void phase_prep(const Args& a, LAS unsigned char* lds, int bid, int G) {
    const int tid = opaque_tid(), lane = tid & 63, wid = tid >> 6;
    unsigned char* ws = a.ws;
    {
        LAS float* tile = (LAS float*)(lds + wid * (64 * 65 * 4));
        for (int it = bid * 8 + wid; it < 704 + 256 + 512; it += G * 8) {
            if (it < 704) p0_transpose_item(a.in[I_WIN], INW, a.in[I_N1W], (bf16_t*)(ws + WS_WINT), it / 44, it % 44, tile, lane);
            else if (it < 960) { const int j = it - 704; p0_transpose_item(a.in[I_WOUT], 1024, nullptr, (bf16_t*)(ws + WS_WOUTT), j / 16, j % 16, tile, lane); }
            else { const int j = it - 960; p0_transpose_item(a.in[I_WQ], 2048, a.in[I_N2W], (bf16_t*)(ws + WS_WQT), j / 32, j % 32, tile, lane); }
        }
    }
    {
        const int g = bid * NTHR + tid;
        if (g < 32768) {
            bf16_t* keys = (bf16_t*)(ws + WS_KEYS);
            const float v = (g < 16384) ? a.in[I_SK1][g] : a.in[I_SK2][g - 16384];
            keys[g] = (bf16_t)f2bf(v);
            const int pos = g >> 3, i = g & 7;
            const float inv_freq = powf(500000.0f, -((float)i * 2.0f / 16.0f));
            const float ang = (float)pos * inv_freq;
            double s, c; sincos_d((double)ang, s, c);
            float* rc = (float*)(ws + WS_ROPE);
            rc[g] = (float)c; rc[32768 + g] = (float)s;
        }
    }
    {
        LAS float* wg = (LAS float*)lds;
        __syncthreads();
        for (int e = tid; e < 8192; e += NTHR) { const int k = e >> 3, j = e & 7; wg[j * 1024 + k] = a.in[I_N1W][k] * a.in[I_WIN][(size_t)k * INW + NPROJ + j]; }
        __syncthreads();
        const float* x = a.in[I_X];
        bf16_t* xb = (bf16_t*)(ws + WS_R1);
        float* rstd1 = (float*)(ws + WS_RSTD1);
        float* gate = (float*)(ws + WS_GATE);
        float* ssq = (float*)(ws + WS_RSTD2);
        const int tstride = G * 8;
        f32x4 v[2][4], vnx[2][4];
        int tok = bid * 8 + wid;
#pragma unroll
        for (int k = 0; k < 2; ++k) { const int t = tok + k * tstride, tc = t < NTOK ? t : tok;
#pragma unroll
            for (int i = 0; i < 4; ++i) v[k][i] = ((const f32x4*)(x + (size_t)tc * DM))[lane + 64 * i]; }
        for (; tok < NTOK; tok += 2 * tstride) {
            const int tn = tok + 2 * tstride;
            if (tn < NTOK) {
#pragma unroll
                for (int k = 0; k < 2; ++k) { const int t = tn + k * tstride, tc = t < NTOK ? t : tn;
#pragma unroll
                    for (int i = 0; i < 4; ++i) vnx[k][i] = ((const f32x4*)(x + (size_t)tc * DM))[lane + 64 * i]; }
            }
#pragma unroll
            for (int k = 0; k < 2; ++k) {
                const int t = tok + k * tstride;
                float ss = 0.f, d[8];
#pragma unroll
                for (int j = 0; j < 8; ++j) d[j] = 0.f;
#pragma unroll
                for (int i = 0; i < 4; ++i) {
                    ss += v[k][i][0] * v[k][i][0] + v[k][i][1] * v[k][i][1] + v[k][i][2] * v[k][i][2] + v[k][i][3] * v[k][i][3];
#pragma unroll
                    for (int j = 0; j < 8; ++j) { const f32x4 w = *(const LAS f32x4*)(wg + j * 1024 + 4 * (lane + 64 * i)); d[j] += v[k][i][0] * w[0] + v[k][i][1] * w[1] + v[k][i][2] * w[2] + v[k][i][3] * w[3]; }
                }
                ss = wave_sum_dpp(ss);
#pragma unroll
                for (int j = 0; j < 8; ++j) d[j] = wave_sum_dpp(d[j]);
                const float rs = rsqrtf(ss * (1.0f / DM) + EPS);
                if (t < NTOK) {
#pragma unroll
                    for (int i = 0; i < 4; ++i) { u32x2 w; w.x = pk2(v[k][i][0], v[k][i][1]); w.y = pk2(v[k][i][2], v[k][i][3]); *(u32x2*)(xb + (size_t)t * DM + 4 * (lane + 64 * i)) = w; }
                    float dl = d[0];
#pragma unroll
                    for (int j = 1; j < 8; ++j) dl = (lane == j) ? d[j] : dl;
                    if (lane < 8) gate[t * 8 + lane] = rs * dl;
                    if (lane == 0) { rstd1[t] = rs; ssq[t] = 0.f; }
                }
            }
#pragma unroll
            for (int k = 0; k < 2; ++k)
#pragma unroll
                for (int i = 0; i < 4; ++i) v[k][i] = vnx[k][i];
        }
    }
}

namespace pg8 {
#define PG8_LAS __attribute__((address_space(3)))
typedef unsigned short bf16_t;
typedef short bf16x8 __attribute__((ext_vector_type(8)));
typedef float f32x4 __attribute__((ext_vector_type(4)));
typedef unsigned u32x4 __attribute__((ext_vector_type(4)));
constexpr int BM = 256, BK = 64, HALF = 128, HTB = HALF * BK * 2  , STAGE_BYTES = 8 * HTB, NXCD = 8, WGM = 8;

__host__ __device__ __forceinline__ int lds_byte(int r, int c) { const int st = (r >> 4) * 2 + (c >> 5), rr = r & 15, cc = c & 31, ob = rr * 64 + cc * 2; return st * 1024 + (ob ^ (((ob >> 9) & 1) << 5)); }
__host__ __device__ __forceinline__ void stage_rc(int b, int& R, int& C) { const int st = b / 1024, sb = b % 1024, swz = sb ^ (((sb >> 9) & 1) << 5); R = (st >> 1) * 16 + swz / 64; C = (st & 1) * 32 + (swz % 64) / 2; }
__host__ __device__ __forceinline__ int perm32(int rho) { const int n = rho >> 4, i = rho & 15; return 8 * (i >> 2) + 4 * n + (i & 3); }

struct Unit { int pm, pn; };
struct Gemm { const bf16_t* A; const bf16_t* Bt; int M, N, K; };

struct StaticOrder {
    int nM, nN, nwg, G, c;
    __host__ __device__ void init(int M, int N, int G_, int c_) { nM = M / BM; nN = N / BM; nwg = nM * nN; G = G_; c = c_; }
    __host__ __device__ bool next(int i, Unit& u) const {
        const long L = (long)i * G + c; if (L >= nwg) return false;
        int wgid = (int)L; { const int q = nwg / NXCD, r = nwg % NXCD, xcd = wgid % NXCD, off = wgid / NXCD; wgid = (xcd < r ? xcd * (q + 1) : r * (q + 1) + (xcd - r) * q) + off; }
        const int nig = WGM * nN, gid = wgid / nig, fm = gid * WGM, gsz = (nM - fm) < WGM ? (nM - fm) : WGM;
        u.pm = fm + ((wgid % nig) % gsz); u.pn = (wgid % nig) / gsz; return true;
    }
    __device__ __forceinline__ void a_ready(const Unit&) const {}
    __device__ __forceinline__ void done(const Unit&) const {}
};
struct FlexOrder {
    StaticOrder so; int panel, pn0, n;
    __device__ bool next(int i, Unit& u) const { if (panel < 0) return so.next(i, u); if (i >= n) return false; u.pm = panel; u.pn = pn0 + i; return true; }
    __device__ __forceinline__ void a_ready(const Unit&) const {}
    __device__ __forceinline__ void done(const Unit&) const {}
};
__device__ __forceinline__ unsigned cvt_pk_bf16(float lo, float hi) { unsigned r; asm volatile("v_cvt_pk_bf16_f32 %0, %1, %2" : "=v"(r) : "v"(lo), "v"(hi)); return r; }
struct EpiProj {
    static constexpr bool PERM = true, AFTER_DRAIN = false;
    bf16_t* att; bf16_t* dqkv; bf16_t* gate; const float* rstd;
    __device__ __forceinline__ void operator()(const f32x4 (&acc)[2][2][4][2], const Unit& u, int wr, int wc, int fr, int fq) const {
        bf16_t* base; int ld, c0;
        if (u.pn < 3) { base = att; ld = 768; c0 = u.pn * 256; } else if (u.pn < 9) { base = dqkv; ld = 1536; c0 = (u.pn - 3) * 256; } else { base = gate; ld = 512; c0 = (u.pn - 9) * 256; }
        const int row0 = u.pm * BM + wr * 64 + fr, col0 = c0 + wc * 32 + 8 * fq;
        const __amdgpu_buffer_rsrc_t rs_out = wt_rsrc(base);
#pragma unroll
        for (int ai = 0; ai < 2; ++ai)
#pragma unroll
            for (int m = 0; m < 4; ++m) {
                const int row = row0 + ai * HALF + m * 16; const float rs = rstd[row];
                const unsigned boff = (unsigned)(((size_t)row * ld + col0) * 2);
#pragma unroll
                for (int bj = 0; bj < 2; ++bj) { const f32x4 v0 = acc[ai][bj][m][0] * rs, v1 = acc[ai][bj][m][1] * rs; u32x4 w; w.x = cvt_pk_bf16(v0[0], v0[1]); w.y = cvt_pk_bf16(v0[2], v0[3]); w.z = cvt_pk_bf16(v1[0], v1[1]); w.w = cvt_pk_bf16(v1[2], v1[3]);
                    wt_store16(rs_out, boff + bj * HALF * 2, w); }
            }
    }
};
struct EpiOut {
    static constexpr bool PERM = true, AFTER_DRAIN = false;
    const float* x; float* out; bf16_t* h2b; float* ssq;
    __device__ __forceinline__ void operator()(const f32x4 (&acc)[2][2][4][2], const Unit& u, int wr, int wc, int fr, int fq) const {
        const int row0 = u.pm * BM + wr * 64 + fr, col0 = u.pn * BM + wc * 32 + 8 * fq;
        const __amdgpu_buffer_rsrc_t rs_h2b = wt_rsrc(h2b);
#pragma unroll
        for (int ai = 0; ai < 2; ++ai)
#pragma unroll
            for (int m = 0; m < 4; ++m) {
                const size_t off = (size_t)(row0 + ai * HALF + m * 16) * 1024 + col0;
                float sq = 0.f;
#pragma unroll
                for (int bj = 0; bj < 2; ++bj) {
                    const f32x4 v0 = *(const f32x4*)(x + off + bj * HALF) + acc[ai][bj][m][0], v1 = *(const f32x4*)(x + off + bj * HALF + 4) + acc[ai][bj][m][1];
                    u32x4 w; w.x = cvt_pk_bf16(v0[0], v0[1]); w.y = cvt_pk_bf16(v0[2], v0[3]); w.z = cvt_pk_bf16(v1[0], v1[1]); w.w = cvt_pk_bf16(v1[2], v1[3]);
                    wt_store16(rs_h2b, (unsigned)((off + bj * HALF) * 2), w);
                    sq += (v0[0] * v0[0] + v0[1] * v0[1]) + (v0[2] * v0[2] + v0[3] * v0[3]) + (v1[0] * v1[0] + v1[1] * v1[1]) + (v1[2] * v1[2] + v1[3] * v1[3]);
                }
                sq += __shfl_xor(sq, 16); sq += __shfl_xor(sq, 32);
                if (fq == 0) atomicAdd(ssq + row0 + ai * HALF + m * 16, sq);
            }
    }
};
struct EpiQry {
    static constexpr bool PERM = true, AFTER_DRAIN = false;
    bf16_t* q;
    __device__ __forceinline__ void operator()(const f32x4 (&acc)[2][2][4][2], const Unit& u, int wr, int wc, int fr, int fq) const {
        const int row0 = u.pm * BM + wr * 64 + fr, col0 = u.pn * BM + wc * 32 + 8 * fq;
        const __amdgpu_buffer_rsrc_t rs_q = wt_rsrc(q);
#pragma unroll
        for (int ai = 0; ai < 2; ++ai)
#pragma unroll
            for (int m = 0; m < 4; ++m) {
                const unsigned boff = (unsigned)(((size_t)(row0 + ai * HALF + m * 16) * 2048 + col0) * 2);
#pragma unroll
                for (int bj = 0; bj < 2; ++bj) { const f32x4 v0 = acc[ai][bj][m][0], v1 = acc[ai][bj][m][1]; u32x4 w; w.x = cvt_pk_bf16(v0[0], v0[1]); w.y = cvt_pk_bf16(v0[2], v0[3]); w.z = cvt_pk_bf16(v1[0], v1[1]); w.w = cvt_pk_bf16(v1[2], v1[3]);
                    wt_store16(rs_q, boff + bj * HALF * 2, w); }
            }
    }
};
template <class Epi, class Sched, bool ALIGN_EPI = false, bool SP2 = false>
__device__ __forceinline__ void gemm_phase(PG8_LAS unsigned char* lds, const Gemm g, const Sched& S, const Epi& E) {
    const int tid = opaque_tid(), wid = __builtin_amdgcn_readfirstlane(tid >> 6), lane = tid & 63, wr = wid >> 2, wc = wid & 3, fr = lane & 15, fq = lane >> 4;
    const int K = g.K, nt = K / BK;
    unsigned voffA[2], voffB[2];
#pragma unroll
    for (int i = 0; i < 2; ++i) { int R, C; stage_rc(tid * 16 + i * 8192, R, C); const int Rb = Epi::PERM ? ((R & ~31) + perm32(R & 31)) : R;
        voffA[i] = (unsigned)(R * K + C) * 2u; voffB[i] = (unsigned)(Rb * K + C) * 2u; }
    const size_t kstep = (size_t)(BK * 2);
    const size_t hstep = (size_t)HALF * K * 2;
    const size_t tstep = 2 * hstep;
    const unsigned ldsw = (unsigned)wid * 1024u;
    const int aoff = lds_byte(wr * 64 + fr, fq * 8), boff = lds_byte(wc * 32 + fr, fq * 8);
#define PG8_SA(b, h) (((b) * 2 + (h)) * HTB)
#define PG8_SB(b, h) ((4 + (b) * 2 + (h)) * HTB)
#define PG8_STAGE(bufoff, gbase, voff) do { _Pragma("unroll") for (int _i = 0; _i < 2; ++_i) \
        __builtin_amdgcn_global_load_lds((const unsigned*)((const char*)(gbase) + (voff)[_i]), (PG8_LAS unsigned*)(lds + (bufoff) + ldsw + _i * 8192), 16, 0, 0); } while (0)
#define PG8_LDA(dst, b, h) do { _Pragma("unroll") for (int m = 0; m < 4; ++m) _Pragma("unroll") for (int k = 0; k < 2; ++k) dst[m][k] = *(const PG8_LAS bf16x8*)(lds + PG8_SA(b, h) + aoff + m * 2048 + k * 1024); } while (0)
#define PG8_LDB(dst, b, h) do { _Pragma("unroll") for (int n = 0; n < 2; ++n) _Pragma("unroll") for (int k = 0; k < 2; ++k) dst[n][k] = *(const PG8_LAS bf16x8*)(lds + PG8_SB(b, h) + boff + n * 2048 + k * 1024); } while (0)
#define PG8_MMA(ai, bj, At, Bt) do { __builtin_amdgcn_s_setprio(1); _Pragma("unroll") for (int m = 0; m < 4; ++m) _Pragma("unroll") for (int n = 0; n < 2; ++n) _Pragma("unroll") for (int k = 0; k < 2; ++k) \
        acc[ai][bj][m][n] = __builtin_amdgcn_mfma_f32_16x16x32_bf16(Bt[n][k], At[m][k], acc[ai][bj][m][n], 0, 0, 0); __builtin_amdgcn_s_setprio(0); } while (0)
#define PG8_WAIT_V(n) asm volatile("s_waitcnt vmcnt(" #n ")" ::: "memory")
#define PG8_WAIT_L(n) asm volatile("s_waitcnt lgkmcnt(" #n ")" ::: "memory")
#define PG8_BAR __builtin_amdgcn_s_barrier()
#define PG8_SCHED __builtin_amdgcn_sched_barrier(0)
    Unit cur, nxt; int ui = 0;
    if (!S.next(0, cur)) return;
    f32x4 acc[2][2][4][2];
#pragma unroll
    for (int a = 0; a < 2; ++a)
#pragma unroll
        for (int b = 0; b < 2; ++b)
#pragma unroll
            for (int m = 0; m < 4; ++m)
#pragma unroll
                for (int n = 0; n < 2; ++n) acc[a][b][m][n] = (f32x4){0.f, 0.f, 0.f, 0.f};
    bf16x8 At[4][2], B0[2][2], B1[2][2];
    const char* cA = (const char*)g.A + (size_t)cur.pm * tstep; const char* cB = (const char*)g.Bt + (size_t)cur.pn * tstep;
    S.a_ready(cur);
    if constexpr (SP2) {
        PG8_STAGE(PG8_SB(0, 0), cB, voffB); PG8_STAGE(PG8_SB(0, 1), cB + hstep, voffB); PG8_STAGE(PG8_SA(0, 0), cA, voffA); PG8_STAGE(PG8_SA(0, 1), cA + hstep, voffA);
        if (wr == 1) PG8_BAR;
        PG8_WAIT_V(2); PG8_BAR;
        PG8_STAGE(PG8_SB(1, 0), cB + kstep, voffB); PG8_STAGE(PG8_SA(1, 0), cA + kstep, voffA); PG8_STAGE(PG8_SB(1, 1), cB + hstep + kstep, voffB);
        PG8_WAIT_V(6); PG8_BAR;
    } else {
        PG8_STAGE(PG8_SB(0, 0), cB, voffB); PG8_STAGE(PG8_SA(0, 0), cA, voffA); PG8_STAGE(PG8_SB(0, 1), cB + hstep, voffB); PG8_STAGE(PG8_SA(0, 1), cA + hstep, voffA);
        if (wr == 1) PG8_BAR;
        PG8_WAIT_V(4); PG8_BAR;
        PG8_STAGE(PG8_SB(1, 0), cB + kstep, voffB); PG8_STAGE(PG8_SA(1, 0), cA + kstep, voffA); PG8_STAGE(PG8_SB(1, 1), cB + hstep + kstep, voffB);
        PG8_WAIT_V(6); PG8_BAR;
    }
    for (;;) {
        const bool has_next = S.next(ui + 1, nxt);
        const char* nA = has_next ? (const char*)g.A + (size_t)nxt.pm * tstep : cA; const char* nB = has_next ? (const char*)g.Bt + (size_t)nxt.pn * tstep : cB;
        for (int t = 0; t < nt; t += 2) {
            const bool last = (t == nt - 2);
            const char* a1 = cA + (size_t)(t + 1) * kstep;
            const char* a2 = last ? nA : cA + (size_t)(t + 2) * kstep; const char* b2 = last ? nB : cB + (size_t)(t + 2) * kstep;
            const char* a3 = a2 + kstep; const char* b3 = b2 + kstep;
            if (last && has_next) S.a_ready(nxt);
            if constexpr (SP2) {
            PG8_LDB(B0, 0, 0); PG8_LDB(B1, 0, 1); PG8_SCHED; PG8_LDA(At, 0, 0); PG8_STAGE(PG8_SA(1, 1), a1 + hstep, voffA);
            PG8_WAIT_V(8); PG8_WAIT_L(0); PG8_BAR; PG8_MMA(0, 0, At, B0); PG8_MMA(0, 1, At, B1); PG8_BAR; PG8_SCHED;
            PG8_LDA(At, 0, 1); PG8_STAGE(PG8_SB(0, 0), b2, voffB); PG8_STAGE(PG8_SB(0, 1), b2 + hstep, voffB); PG8_STAGE(PG8_SA(0, 0), a2, voffA);
            PG8_WAIT_V(8); PG8_WAIT_L(0); PG8_BAR; PG8_MMA(1, 0, At, B0); PG8_MMA(1, 1, At, B1); PG8_BAR; PG8_SCHED;
            PG8_LDB(B0, 1, 0); PG8_LDB(B1, 1, 1); PG8_SCHED; PG8_LDA(At, 1, 0); PG8_STAGE(PG8_SA(0, 1), a2 + hstep, voffA);
            PG8_WAIT_V(8); PG8_WAIT_L(0); PG8_BAR; PG8_MMA(0, 0, At, B0); PG8_MMA(0, 1, At, B1); PG8_BAR; PG8_SCHED;
            PG8_LDA(At, 1, 1); PG8_STAGE(PG8_SB(1, 0), b3, voffB); PG8_STAGE(PG8_SB(1, 1), b3 + hstep, voffB); PG8_STAGE(PG8_SA(1, 0), a3, voffA);
            PG8_WAIT_V(8); PG8_WAIT_L(0); PG8_BAR; PG8_MMA(1, 0, At, B0); PG8_MMA(1, 1, At, B1); PG8_BAR; PG8_SCHED;
            } else {
            PG8_LDB(B0, 0, 0); PG8_SCHED; PG8_LDA(At, 0, 0); PG8_STAGE(PG8_SA(1, 1), a1 + hstep, voffA);
            PG8_WAIT_L(8); PG8_BAR; PG8_WAIT_L(0); PG8_MMA(0, 0, At, B0); PG8_BAR; PG8_SCHED;
            PG8_LDB(B1, 0, 1); PG8_STAGE(PG8_SB(0, 0), b2, voffB);
            PG8_BAR; PG8_WAIT_L(0); PG8_MMA(0, 1, At, B1); PG8_BAR;
            PG8_LDA(At, 0, 1); PG8_STAGE(PG8_SA(0, 0), a2, voffA);
            PG8_BAR; PG8_WAIT_L(0); PG8_MMA(1, 0, At, B0); PG8_BAR; PG8_SCHED;
            PG8_STAGE(PG8_SB(0, 1), b2 + hstep, voffB);
            PG8_WAIT_V(6); PG8_BAR; PG8_MMA(1, 1, At, B1); PG8_BAR;
            PG8_LDB(B0, 1, 0); PG8_SCHED; PG8_LDA(At, 1, 0); PG8_STAGE(PG8_SA(0, 1), a2 + hstep, voffA);
            PG8_WAIT_L(8); PG8_BAR; PG8_WAIT_L(0); PG8_MMA(0, 0, At, B0); PG8_BAR; PG8_SCHED;
            PG8_LDB(B1, 1, 1); PG8_STAGE(PG8_SB(1, 0), b3, voffB);
            PG8_BAR; PG8_WAIT_L(0); PG8_MMA(0, 1, At, B1); PG8_BAR;
            PG8_LDA(At, 1, 1); PG8_STAGE(PG8_SA(1, 0), a3, voffA);
            PG8_BAR; PG8_WAIT_L(0); PG8_MMA(1, 0, At, B0); PG8_BAR; PG8_SCHED;
            PG8_STAGE(PG8_SB(1, 1), b3 + hstep, voffB);
            PG8_WAIT_V(6); PG8_BAR; PG8_MMA(1, 1, At, B1); PG8_BAR;
            }
        }
        if constexpr (ALIGN_EPI) { if (wr == 0) PG8_BAR; }
        if constexpr (!Epi::AFTER_DRAIN) { E(acc, cur, wr, wc, fr, fq); S.done(cur); }
        if (!has_next) break;
#pragma unroll
        for (int a = 0; a < 2; ++a)
#pragma unroll
            for (int b = 0; b < 2; ++b)
#pragma unroll
                for (int m = 0; m < 4; ++m)
#pragma unroll
                    for (int n = 0; n < 2; ++n) acc[a][b][m][n] = (f32x4){0.f, 0.f, 0.f, 0.f};
        cur = nxt; cA = nA; cB = nB; ++ui;
        if constexpr (ALIGN_EPI) { if (wr == 1) PG8_BAR; }
    }
    PG8_WAIT_V(0);
    if constexpr (!ALIGN_EPI) { if (wr == 0) PG8_BAR; }
    PG8_BAR;
    if constexpr (Epi::AFTER_DRAIN) { E.fused(acc, cur, wr, wc, fr, fq, lds, wid, lane); S.done(cur); }
#undef PG8_SA
#undef PG8_SB
#undef PG8_STAGE
#undef PG8_LDA
#undef PG8_LDB
#undef PG8_MMA
#undef PG8_WAIT_V
#undef PG8_WAIT_L
#undef PG8_BAR
#undef PG8_SCHED
}
}

DI void phase_qknorm(const Args& a, int bid, int G) {
    const int tid = opaque_tid();
    unsigned char* ws = a.ws;
    const bf16_t* patt = (const bf16_t*)(ws + WS_R2);
    bf16_t* Qn = (bf16_t*)(ws + WS_R5);
    bf16_t* Kn = Qn + (size_t)NTOK * 512;
    const float* rc = (const float*)(ws + WS_ROPE);
    const int sub = tid & 15;
    const int stride = (G * NTHR) >> 4, NIT = NTOK * 10;
    f32x4 nwq, nwk;
    nwq = *(const f32x4*)(a.in[I_QNW] + 4 * sub); nwk = *(const f32x4*)(a.in[I_KNW] + 4 * sub);
    for (int item0 = (bid * NTHR + tid) >> 4; item0 < NIT; item0 += 4 * stride) {
        u32x2 raw[4];
#pragma unroll
        for (int k = 0; k < 4; ++k) {
            const int item = item0 + k * stride, ic = item < NIT ? item : item0;
            raw[k] = *(const u32x2*)(patt + (size_t)(ic / 10) * 768 + (ic % 10) * 64 + 4 * sub);
        }
#pragma unroll
        for (int k = 0; k < 4; ++k) {
            const int item = item0 + k * stride, ic = item < NIT ? item : item0;
            const int tok = ic / 10, hh = ic % 10, pos = tok & (SEQ - 1);
            float v[4] = {bflo(raw[k].x), bfhi(raw[k].x), bflo(raw[k].y), bfhi(raw[k].y)};
            float ss = v[0] * v[0] + v[1] * v[1] + v[2] * v[2] + v[3] * v[3];
            ss += dppf<0xB1>(ss); ss += dppf<0x4E>(ss); ss += dppf<0x141>(ss); ss += dppf<0x140>(ss);
            const float rs = rsqrtf(ss * (1.0f / 64.0f) + EPS);
            const f32x4 nw = (hh < 8) ? nwq : nwk;
            float y[4], p[4];
#pragma unroll
            for (int e = 0; e < 4; ++e) y[e] = v[e] * rs * nw[e];
#pragma unroll
            for (int e = 0; e < 4; ++e) p[e] = dppf<0x4E>(y[e]);
            if (sub < 4) {
                const f32x4 c4 = *(const f32x4*)(rc + pos * 8 + 4 * (sub & 1)), s4 = *(const f32x4*)(rc + 32768 + pos * 8 + 4 * (sub & 1));
#pragma unroll
                for (int e = 0; e < 4; ++e) y[e] = (sub < 2) ? (y[e] * c4[e] - p[e] * s4[e]) : (y[e] * c4[e] + p[e] * s4[e]);
            }
            const float sc = (hh < 8) ? 0.125f : 1.0f;
            u32x2 w; w.x = pk2(y[0] * sc, y[1] * sc); w.y = pk2(y[2] * sc, y[3] * sc);
            if (item < NIT) {
                if (hh < 8) *(u32x2*)(Qn + (size_t)tok * 512 + hh * 64 + 4 * sub) = w;
                else *(u32x2*)(Kn + (size_t)tok * 128 + (hh - 8) * 64 + 4 * sub) = w;
            }
        }
    }
}

constexpr int DP_ROW = 272;
constexpr int DP_IMG = 64 * DP_ROW;
constexpr int DP_HALF = 4 * DP_IMG;
constexpr int DP_SMALL = 2 * DP_HALF;
DI void phase_dnprep(const Args& a, LAS unsigned char* lds, int bid, int G) {
    unsigned char* ws = a.ws;
    const bf16_t* pd = (const bf16_t*)(ws + WS_R3);
    const float* gate = (const float*)(ws + WS_GATE);
    const float* cw = a.in[I_CONVW];
    for (int up = bid; up < 512; up += G) {
        int tid = threadIdx.x;
        asm volatile("" : "+v"(tid));
        const int half = tid >> 8, ht = tid & 255, lane = tid & 63, hw = ht >> 6, fr = lane & 15, fq = lane >> 4;
        LAS unsigned char* qs = lds + half * DP_HALF;
        LAS unsigned char* ks = qs + DP_IMG;
        LAS unsigned char* vs = ks + DP_IMG;
        LAS float* Lm = (LAS float*)(vs + DP_IMG);
        LAS float* gc = (LAS float*)(lds + DP_SMALL + half * 512);
        LAS float* bt = gc + 64;
        LAS float* fb = (LAS float*)(lds + DP_SMALL + 1024 + half * 256);
        LAS float* eg = (LAS float*)(lds + DP_SMALL + 1536 + half * 512);
        LAS float* ek = eg + 64;
        const int unit = up * 2 + half;
        const int n = unit & 63, h = (unit >> 6) & 3, b = unit >> 8;
        const int c0 = n * 64, tok0 = b * SEQ + c0;
        unsigned char* ub = ws + WS_R6 + (size_t)unit * DN_UNIT_BYTES;
        __syncthreads();
#ifndef DP_S1
#define DP_S1 1
#define DP_S2 1
#define DP_S3 1
#endif
#pragma unroll 1
        for (int r1_ = 0; r1_ < DP_S1; ++r1_) {
            unsigned raw[3][19];
#pragma unroll
            for (int which = 0; which < 3; ++which) {
                const int cb = which * 512 + h * 128 + 2 * lane;
#pragma unroll
                for (int r = 0; r < 19; ++r) {
                    const int t = c0 + 16 * hw - 3 + r;
                    raw[which][r] = (t >= 0) ? *(const unsigned*)(pd + (size_t)(b * SEQ + (t >= 0 ? t : 0)) * 1536 + cb) : 0u;
                }
            }
#pragma unroll
            for (int which = 0; which < 3; ++which) {
                const int cb = which * 512 + h * 128 + 2 * lane;
                float w0[4], w1[4];
#pragma unroll
                for (int j = 0; j < 4; ++j) { const f32x2 w = *(const f32x2*)(cw + j * 1536 + cb); w0[j] = w[0]; w1[j] = w[1]; }
                LAS unsigned char* img = qs + which * DP_IMG;
#pragma unroll
                for (int ii = 0; ii < 16; ++ii) {
                    float y0 = 0.f, y1 = 0.f;
#pragma unroll
                    for (int j = 0; j < 4; ++j) { y0 += w0[j] * bflo(raw[which][ii + j]); y1 += w1[j] * bfhi(raw[which][ii + j]); }
                    y0 = siluf_(y0); y1 = siluf_(y1);
                    if (which < 2) {
                        const float ss = wave_sum_dpp(y0 * y0 + y1 * y1);
                        float sc = rsqrtf(ss + EPS);
                        if (which == 0) sc *= 0.08838834764831845f;
                        y0 *= sc; y1 *= sc;
                    }
                    *(LAS unsigned*)(img + (16 * hw + ii) * DP_ROW + 4 * lane) = pk2(y0, y1);
                }
            }
        }
        if (hw == 0) {
            const float bb = gate[(size_t)(tok0 + lane) * 8 + h], aa = gate[(size_t)(tok0 + lane) * 8 + 4 + h];
            const float xx = aa + a.in[I_DTB][h];
            const float sp = (xx > 20.f) ? xx : log1pf(expf(xx));
            float g = -expf(a.in[I_ALOG][h]) * sp;
#pragma unroll
            for (int o = 1; o < 64; o <<= 1) { const float t = __shfl_up(g, o); if (lane >= o) g += t; }
            const float be = sigmoidf_(bb);
            const float eg_ = __expf(g), g63_ = __shfl(g, 63);
            gc[lane] = g; bt[lane] = be; fb[lane] = be * eg_; eg[lane] = eg_; ek[lane] = __expf(g63_ - g);
        }
        __syncthreads();
#pragma unroll 1
        for (int r2_ = 0; r2_ < DP_S2; ++r2_) {
            const int it = hw;
            const int i = 16 * it + fr;
            const float gi = gc[i], bi = bt[i];
            bf16_t* intra = (bf16_t*)(ub + 49152);
#pragma unroll
            for (int jp = 0; jp < 2; ++jp) {
                u32x4 wv;
#pragma unroll
                for (int jh = 0; jh < 2; ++jh) {
                    const int jt = 2 * jp + jh;
                    f32x4 akk = {0.f, 0.f, 0.f, 0.f}, aqk = {0.f, 0.f, 0.f, 0.f};
#pragma unroll
                    for (int s = 0; s < 4; ++s) {
                        const bf16x8 A = *(const LAS bf16x8*)(ks + (16 * jt + fr) * DP_ROW + s * 64 + fq * 16);
                        const bf16x8 Bk = *(const LAS bf16x8*)(ks + (16 * it + fr) * DP_ROW + s * 64 + fq * 16);
                        const bf16x8 Bq = *(const LAS bf16x8*)(qs + (16 * it + fr) * DP_ROW + s * 64 + fq * 16);
                        akk = mfma16(A, Bk, akk); aqk = mfma16(A, Bq, aqk);
                    }
                    f32x4 lv, iv;
#pragma unroll
                    for (int r = 0; r < 4; ++r) {
                        const int j = 16 * jt + 4 * fq + r;
                        const float dec = (j <= i) ? __expf(gi - gc[j]) : 0.f;
                        lv[r] = (j < i) ? bi * akk[r] * dec : 0.f;
                        iv[r] = aqk[r] * dec;
                    }
                    *(LAS f32x4*)(Lm + i * 68 + 16 * jt + 4 * fq) = lv;
                    if (jh == 0) { wv.x = pk2(iv[0], iv[1]); wv.y = pk2(iv[2], iv[3]); } else { wv.z = pk2(iv[0], iv[1]); wv.w = pk2(iv[2], iv[3]); }
                }
                *(u32x4*)(intra + i * 64 + 32 * jp + 8 * fq) = wv;
            }
        }
        __syncthreads();
        {
            const int j = lane & 15;
            const LAS float* Lb = Lm + (16 * hw) * 68 + 16 * hw;
            float t[16];
#pragma unroll
            for (int i = 0; i < 16; ++i) {
                float acc = (i == j) ? 1.f : 0.f;
#pragma unroll
                for (int k4 = 0; k4 < i; k4 += 4) {
                    const f32x4 l = *(const LAS f32x4*)(Lb + i * 68 + k4);
                    acc -= l[0] * t[k4];
                    if (k4 + 1 < i) acc -= l[1] * t[k4 + 1];
                    if (k4 + 2 < i) acc -= l[2] * t[k4 + 2];
                    if (k4 + 3 < i) acc -= l[3] * t[k4 + 3];
                }
                t[i] = acc;
            }
            asm volatile("s_waitcnt lgkmcnt(0)" ::: "memory");
#pragma unroll
            for (int i = 0; i < 16; ++i) *(LAS float*)(Lm + (16 * hw + i) * 68 + 16 * hw + j) = t[i];
        }
        __syncthreads();
        f32x4 U[4][4];
        {
            const LAS unsigned char* src = (hw < 2) ? (vs + 2 * (64 * hw)) : (ks + 2 * (64 * (hw - 2)));
            const LAS float* fac = (hw < 2) ? bt : fb;
            f32x4 R[4][4];
#pragma unroll
            for (int ct = 0; ct < 4; ++ct)
#pragma unroll
                for (int bb = 0; bb < 4; ++bb)
#pragma unroll
                    for (int r = 0; r < 4; ++r) { const int i = 16 * bb + 4 * fq + r; R[ct][bb][r] = bf2f(*(const LAS bf16_t*)(src + i * DP_ROW + 2 * (16 * ct + fr))) * fac[i]; }
            u32x2 Ub16[4][4];
#pragma unroll
            for (int bb = 0; bb < 4; ++bb) {
                f32x4 X[4];
#pragma unroll
                for (int ct = 0; ct < 4; ++ct) X[ct] = (f32x4){0.f, 0.f, 0.f, 0.f};
#pragma unroll
                for (int c = 0; c < bb; c += 2) {
                    const f32x4 a0 = *(const LAS f32x4*)(Lm + (16 * bb + fr) * 68 + 16 * c + 4 * fq);
                    f32x4 a1 = {0.f, 0.f, 0.f, 0.f};
                    if (c + 1 < bb) a1 = *(const LAS f32x4*)(Lm + (16 * bb + fr) * 68 + 16 * (c + 1) + 4 * fq);
                    const bf16x8 A = pack8(a0, a1);
#pragma unroll
                    for (int ct = 0; ct < 4; ++ct) {
                        const u32x2 z = {0u, 0u};
                        const bf16x8 B = cat8(Ub16[ct][c], (c + 1 < bb) ? Ub16[ct][c + 1] : z);
                        X[ct] = mfma16(A, B, X[ct]);
                    }
                }
                const f32x4 tv = *(const LAS f32x4*)(Lm + (16 * bb + fr) * 68 + 16 * bb + 4 * fq);
                const bf16x8 AT = pack8(tv, (f32x4){0.f, 0.f, 0.f, 0.f});
#pragma unroll
                for (int ct = 0; ct < 4; ++ct) {
                    const f32x4 Rp = R[ct][bb] - X[ct];
                    u32x2 rp16; rp16.x = pk2(Rp[0], Rp[1]); rp16.y = pk2(Rp[2], Rp[3]);
                    const u32x2 z = {0u, 0u};
                    const f32x4 Ub = mfma16(AT, cat8(rp16, z), (f32x4){0.f, 0.f, 0.f, 0.f});
                    U[ct][bb] = Ub;
                    Ub16[ct][bb].x = pk2(Ub[0], Ub[1]); Ub16[ct][bb].y = pk2(Ub[2], Ub[3]);
                }
            }
        }
        __syncthreads();
        LAS unsigned char* img_k = (LAS unsigned char*)Lm;
        {
            bf16_t* qd = (bf16_t*)(ub + 16384);
            const int c16 = ht & 15, cc = c16 >> 2, k = c16 & 3;
#pragma unroll
            for (int itr = 0; itr < 4; ++itr) {
                const int i = (ht >> 4) + 16 * itr;
                const float e = eg[i];
                const u32x2 r0 = *(const LAS u32x2*)(qs + i * DP_ROW + cc * 64 + k * 8), r1 = *(const LAS u32x2*)(qs + i * DP_ROW + cc * 64 + 32 + k * 8);
                u32x4 w;
                w.x = pk2(bflo(r0.x) * e, bfhi(r0.x) * e); w.y = pk2(bflo(r0.y) * e, bfhi(r0.y) * e);
                w.z = pk2(bflo(r1.x) * e, bfhi(r1.x) * e); w.w = pk2(bflo(r1.y) * e, bfhi(r1.y) * e);
                *(u32x4*)(qd + i * 128 + c16 * 8) = w;
            }
            const int d = ht & 127, ih = ht >> 7;
#pragma unroll
            for (int k2 = 0; k2 < 4; ++k2) {
                float v[8];
#pragma unroll
                for (int e2 = 0; e2 < 8; ++e2) { const int ii = 32 * ih + 16 * (e2 >> 2) + 4 * k2 + (e2 & 3); v[e2] = bf2f(*(const LAS bf16_t*)(ks + ii * DP_ROW + 2 * d)) * ek[ii]; }
                u32x4 w; w.x = pk2(v[0], v[1]); w.y = pk2(v[2], v[3]); w.z = pk2(v[4], v[5]); w.w = pk2(v[6], v[7]);
                *(LAS u32x4*)(img_k + d * 128 + (((4 * ih + k2) ^ (d & 7)) * 16)) = w;
            }
            if (ht == 0) ((float*)(ws + WS_GL))[unit] = eg[63];
            if (hw >= 2) {
#pragma unroll
                for (int ct = 0; ct < 4; ++ct) {
                    const int cc2 = 64 * (hw - 2) + 16 * ct + fr, cp = (cc2 & ~31) | (((cc2 >> 2) & 3) << 3) | (((cc2 >> 4) & 1) << 2) | (cc2 & 3);
#pragma unroll
                    for (int bb = 0; bb < 4; ++bb)
#pragma unroll
                        for (int r = 0; r < 4; ++r) *(LAS bf16_t*)(vs + (16 * bb + 4 * fq + r) * DP_ROW + 2 * cp) = (bf16_t)f2bf(U[ct][bb][r]);
                }
            }
        }
        __syncthreads();
        {
            if (hw < 2) {
#pragma unroll
                for (int ct = 0; ct < 4; ++ct) {
                    const int dv = 64 * hw + 16 * ct + fr;
#pragma unroll
                    for (int bb = 0; bb < 4; ++bb) {
                        u32x2 w; w.x = pk2(U[ct][bb][0], U[ct][bb][1]); w.y = pk2(U[ct][bb][2], U[ct][bb][3]);
                        *(LAS u32x2*)(qs + dv * 128 + (((2 * bb + (fq >> 1)) ^ (dv & 7)) * 16) + 8 * (fq & 1)) = w;
                    }
                }
            }
            bf16_t* kdT = (bf16_t*)(ub + 32768);
            bf16_t* wout = (bf16_t*)ub;
#pragma unroll
            for (int k = 0; k < 4; ++k) {
                const int cid = ht + 256 * k;
                { const int row = cid >> 3, c = cid & 7; *(u32x4*)(kdT + row * 64 + c * 8) = *(const LAS u32x4*)(img_k + row * 128 + ((c ^ (row & 7)) * 16)); }
                { const int row = cid >> 4, c16 = cid & 15; *(u32x4*)(wout + row * 128 + c16 * 8) = *(const LAS u32x4*)(vs + row * DP_ROW + c16 * 16); }
            }
        }
        __syncthreads();
        {
            bf16_t* uT = (bf16_t*)(ub + 57344);
#pragma unroll
            for (int k = 0; k < 4; ++k) {
                const int cid = ht + 256 * k, row = cid >> 3, c = cid & 7;
                *(u32x4*)(uT + row * 64 + c * 8) = *(const LAS u32x4*)(qs + row * 128 + ((c ^ (row & 7)) * 16));
            }
        }
    }
}

constexpr int AT_KROW = 144, AT_KSZ = 208 * AT_KROW;
constexpr int AT_VROW = 432;
DI void attn_unit(const Args& a, LAS unsigned char* lds, int unit) {
    const int tid = opaque_tid(), lane = tid & 63, wid = tid >> 6, fr = lane & 15, fq = lane >> 4;
    unsigned char* ws = a.ws;
    const bf16_t* Qn = (const bf16_t*)(ws + WS_R5);
    const bf16_t* Kn = Qn + (size_t)NTOK * 512;
    const bf16_t* patt = (const bf16_t*)(ws + WS_R2);
    bf16_t* mix = (bf16_t*)(ws + WS_R1);
    const int qh = unit & 1, hkv = (unit >> 1) & 1, blk = (unit >> 2) & 31, b = unit >> 7;
    const int Q0 = blk * 128 + qh * 64;
    LAS unsigned char* Ks = lds;
    LAS unsigned char* VT = lds + AT_KSZ;
    __syncthreads();
    for (int cid = tid; cid < 208 * 8; cid += NTHR) {
        const int kk = cid >> 3, c = cid & 7, key = Q0 - 128 + kk;
        u32x4 kv = {0u, 0u, 0u, 0u}, vv = {0u, 0u, 0u, 0u};
        if (key >= 0 && kk < 192) {
            kv = *(const u32x4*)(Kn + (size_t)(b * SEQ + key) * 128 + hkv * 64 + c * 8);
            vv = *(const u32x4*)(patt + (size_t)(b * SEQ + key) * 768 + 640 + hkv * 64 + c * 8);
        }
        *(LAS u32x4*)(Ks + kk * AT_KROW + c * 16) = kv;
        const unsigned vw[4] = {vv.x, vv.y, vv.z, vv.w};
#pragma unroll
        for (int e = 0; e < 4; ++e) {
            *(LAS bf16_t*)(VT + (c * 8 + 2 * e) * AT_VROW + 2 * kk) = (bf16_t)(vw[e] & 0xffffu);
            *(LAS bf16_t*)(VT + (c * 8 + 2 * e + 1) * AT_VROW + 2 * kk) = (bf16_t)(vw[e] >> 16);
        }
    }
    __syncthreads();
#pragma unroll 1
    for (int it = 0; it < 2; ++it) {
        const int wu = wid + 8 * it, g = wu & 3, i4 = wu >> 2, h = hkv * 4 + g;
        const int qpos = Q0 + 16 * i4 + fr;
        const size_t tok = (size_t)b * SEQ + qpos;
        bf16x8 bq[2];
#pragma unroll
        for (int s = 0; s < 2; ++s) bq[s] = *(const bf16x8*)(Qn + tok * 512 + h * 64 + 32 * s + 8 * fq);
        const float sink = a.in[I_SINK][h];
        f32x4 sc[10];
        float mx = -3.0e38f;
#pragma unroll
        for (int t = 0; t < 10; ++t) {
            f32x4 acc = {0.f, 0.f, 0.f, 0.f};
#pragma unroll
            for (int s = 0; s < 2; ++s) { const bf16x8 A = *(const LAS bf16x8*)(Ks + (16 * (i4 + t) + fr) * AT_KROW + s * 64 + fq * 16); acc = mfma16(A, bq[s], acc); }
#pragma unroll
            for (int r = 0; r < 4; ++r) {
                const int kpos = Q0 - 128 + 16 * (i4 + t) + 4 * fq + r;
                const bool valid = (kpos >= 0) && (kpos <= qpos) && (kpos >= qpos - 127);
                acc[r] = valid ? acc[r] : -3.0e38f;
                mx = fmaxf(mx, acc[r]);
            }
            sc[t] = acc;
        }
        mx = fmaxf(mx, __shfl_xor(mx, 16)); mx = fmaxf(mx, __shfl_xor(mx, 32));
        mx = fmaxf(mx, sink);
        float sum = 0.f;
#pragma unroll
        for (int t = 0; t < 10; ++t)
#pragma unroll
            for (int r = 0; r < 4; ++r) { const float p = (sc[t][r] > -1.0e38f) ? __expf(sc[t][r] - mx) : 0.f; sc[t][r] = p; sum += p; }
        sum += __shfl_xor(sum, 16); sum += __shfl_xor(sum, 32);
        const float inv = 1.0f / (sum + __expf(sink - mx));
        bf16x8 bp[5];
#pragma unroll
        for (int kp = 0; kp < 5; ++kp) bp[kp] = pack8(sc[2 * kp], sc[2 * kp + 1]);
#pragma unroll
        for (int mt = 0; mt < 4; ++mt) {
            f32x4 o = {0.f, 0.f, 0.f, 0.f};
#pragma unroll
            for (int kp = 0; kp < 5; ++kp) {
                const LAS unsigned char* vp = VT + (16 * mt + fr) * AT_VROW + 2 * (16 * (i4 + 2 * kp) + 4 * fq);
                const bf16x8 A = cat8(*(const LAS u32x2*)vp, *(const LAS u32x2*)(vp + 32));
                o = mfma16(A, bp[kp], o);
            }
            u32x2 w; w.x = pk2(o[0] * inv, o[1] * inv); w.y = pk2(o[2] * inv, o[3] * inv);
            *(u32x2*)(mix + tok * DM + h * 64 + 16 * mt + 4 * fq) = w;
        }
    }
}

#ifndef S2_PARTS
#define S2_PARTS 4
#endif
#ifndef TAB_SPLIT
#define TAB_SPLIT 15360
#endif
#ifndef UP_EARLY
#define UP_EARLY 8192
#endif
constexpr int S2_CW = 8 / S2_PARTS, S2_NBLK = 16 * S2_PARTS;
constexpr int S2_W = 0, S2_KD = 17408, S2_BUF = 17408 + 18432;
constexpr size_t WS_SB = WS_R3;
#define S2_GLOAD(rg_, n_) do { const unsigned char* ub_ = base + (size_t)(n_) * DN_UNIT_BYTES + (size_t)lt * 16; _Pragma("unroll") for (int i = 0; i < 8; ++i) \
        rg_[i] = *(const u32x4*)(ub_ + (i < 4 ? i * 4096 : 32768 + (i - 4) * 4096)); } while (0)
#define S2_LSTORE(rg_, buf_) do { _Pragma("unroll") for (int i = 0; i < 8; ++i) *(LAS u32x4*)(lds + (buf_) * S2_BUF + dst[i]) = rg_[i]; } while (0)
#define S2_ULOAD(u_, n_) do { const bf16_t* uT_ = (const bf16_t*)(base + (size_t)(n_) * DN_UNIT_BYTES + 57344) + (cbase + fr) * 64 + 4 * fq; \
        _Pragma("unroll") for (int m = 0; m < 4; ++m) u_[m] = *(const u32x2*)(uT_ + 16 * m); } while (0)
template <bool DO_ULOAD>
DI void scan2_step_compute(LAS unsigned char* lds, unsigned char* base, unsigned char* sbp, const float glv, int n,
                           const u32x2 (&uc)[4], u32x2 (&un)[4], f32x4 (&S)[8], bf16x8 (&BS)[4], int cbase, int fr, int fq, int lane) {
    const int buf = n & 1;
    if (DO_ULOAD) S2_ULOAD(un, n + 1);
    const LAS unsigned char* L = lds + buf * S2_BUF;
    const float gl = __int_as_float(__builtin_amdgcn_readlane(__float_as_int(glv), n));
    {
        unsigned char* p = sbp + (size_t)n * 32768 + lane * 16;
#pragma unroll
        for (int s = 0; s < 4; ++s) *(u32x4*)(p + s * 1024) = __builtin_bit_cast(u32x4, BS[s]);
    }
    const LAS unsigned char* Lw = L + S2_W + fr * 272 + 16 * fq;
    const LAS unsigned char* Lk = L + S2_KD + fr * 144 + 16 * fq;
#define RD_A(f_, Lx_, m_) do { _Pragma("unroll") for (int s_ = 0; s_ < 4; ++s_) { f_[s_] = *(const LAS bf16x8*)(Lx_ + (m_) * 16 * 272 + 64 * s_); f_[4 + s_] = *(const LAS bf16x8*)(Lx_ + ((m_) + 1) * 16 * 272 + 64 * s_); } } while (0)
#define MM_A(f_, X_, m_) do { _Pragma("unroll") for (int s_ = 0; s_ < 4; ++s_) { X_[m_] = mfma16(f_[s_], BS[s_], X_[m_]); X_[(m_) + 1] = mfma16(f_[4 + s_], BS[s_], X_[(m_) + 1]); } } while (0)
#define RD_KD(f_, t0_) do { _Pragma("unroll") for (int t_ = 0; t_ < 4; ++t_) { f_[2 * t_] = *(const LAS bf16x8*)(Lk + ((t0_) + t_) * 16 * 144); f_[2 * t_ + 1] = *(const LAS bf16x8*)(Lk + ((t0_) + t_) * 16 * 144 + 64); } } while (0)
#define MM_KD(f_, t0_) do { _Pragma("unroll") for (int t_ = 0; t_ < 4; ++t_) { S[(t0_) + t_] = mfma16(f_[2 * t_], BV[0], S[(t0_) + t_]); S[(t0_) + t_] = mfma16(f_[2 * t_ + 1], BV[1], S[(t0_) + t_]); } } while (0)
#define SB() __builtin_amdgcn_sched_barrier(0)
    f32x4 P[4];
#pragma unroll
    for (int m = 0; m < 4; ++m) P[m] = (f32x4){0.f, 0.f, 0.f, 0.f};
    bf16x8 fa[8], fb[8];
    RD_A(fa, Lw, 0); SB();
    RD_A(fb, Lw, 2); MM_A(fa, P, 0); SB();
    RD_KD(fa, 0);    MM_A(fb, P, 2); SB();
    f32x4 vn[4];
#pragma unroll
    for (int m = 0; m < 4; ++m) vn[m] = (f32x4){bflo(uc[m].x), bfhi(uc[m].x), bflo(uc[m].y), bfhi(uc[m].y)} - P[m];
    bf16x8 BV[2];
    BV[0] = pack8(vn[0], vn[1]); BV[1] = pack8(vn[2], vn[3]);
    {
        unsigned char* p = base + (size_t)n * DN_UNIT_BYTES + 57344 + (cbase >> 4) * 2048 + lane * 16;
        *(u32x4*)p = __builtin_bit_cast(u32x4, BV[0]); *(u32x4*)(p + 1024) = __builtin_bit_cast(u32x4, BV[1]);
    }
#pragma unroll
    for (int t = 0; t < 8; ++t) S[t] = S[t] * gl;
    RD_KD(fb, 4); MM_KD(fa, 0); SB();
    MM_KD(fb, 4);
#pragma unroll
    for (int s = 0; s < 4; ++s) BS[s] = pack8(S[2 * s], S[2 * s + 1]);
#undef RD_A
#undef MM_A
#undef RD_KD
#undef MM_KD
#undef SB
    __syncthreads();
}
template <bool DO_LSTORE, bool DO_GLOAD>
DI void scan2_step_load(LAS unsigned char* lds, const unsigned char* base, int n, const int (&dst)[8], u32x4 (&rr)[8], int lt) {
    const int buf = n & 1;
    if (DO_LSTORE) S2_LSTORE(rr, buf ^ 1);
    if (DO_GLOAD) S2_GLOAD(rr, n + 5);
    __syncthreads();
}
DI void scan2_unit(const Args& a, LAS unsigned char* lds, int sunit) {
    int tid = threadIdx.x;
    asm volatile("" : "+v"(tid));
    const int lane = tid & 63, wid = __builtin_amdgcn_readfirstlane(tid >> 6), fr = lane & 15, fq = lane >> 4;
    unsigned char* ws = a.ws;
    const int unit = sunit & 15, part = sunit >> 4, cbase = (128 / S2_PARTS) * part + 16 * (wid & (S2_CW - 1));
    unsigned char* base = ws + WS_R6 + (size_t)unit * 64 * DN_UNIT_BYTES;
    float glv = ((const float*)(ws + WS_GL))[unit * 64 + lane];
    asm volatile("v_mov_b32 %0, %0" : "+v"(glv));
    __syncthreads();
    if (wid < S2_CW) {
        unsigned char* sbp = ws + WS_SB + ((size_t)(unit * 64) * 8 + (cbase >> 4)) * 4096;
        f32x4 S[8]; bf16x8 BS[4]; u32x2 U0[4], U1[4];
#pragma unroll
        for (int t = 0; t < 8; ++t) S[t] = (f32x4){0.f, 0.f, 0.f, 0.f};
#pragma unroll
        for (int s = 0; s < 4; ++s) BS[s] = (bf16x8){0, 0, 0, 0, 0, 0, 0, 0};
        S2_ULOAD(U0, 0);
        __syncthreads();
#pragma unroll 1
        for (int n = 0; n < 62; n += 2) {
            scan2_step_compute<true>(lds, base, sbp, glv, n, U0, U1, S, BS, cbase, fr, fq, lane);
            scan2_step_compute<true>(lds, base, sbp, glv, n + 1, U1, U0, S, BS, cbase, fr, fq, lane);
        }
        scan2_step_compute<true>(lds, base, sbp, glv, 62, U0, U1, S, BS, cbase, fr, fq, lane);
        scan2_step_compute<false>(lds, base, sbp, glv, 63, U1, U0, S, BS, cbase, fr, fq, lane);
    } else if (wid < S2_CW + 4) {
        const int lt = tid - 64 * S2_CW;
        u32x4 R0[8], R1[8], R2[8], R3[8];
        int dst[8];
#pragma unroll
        for (int i = 0; i < 8; ++i) { const int g = lt + 256 * (i & 3); dst[i] = (i < 4) ? (S2_W + (g >> 4) * 272 + (g & 15) * 16) : (S2_KD + (g >> 3) * 144 + (g & 7) * 16); }
        S2_GLOAD(R0, 0); S2_GLOAD(R1, 1); S2_GLOAD(R2, 2); S2_GLOAD(R3, 3);
        S2_LSTORE(R0, 0);
        S2_GLOAD(R0, 4);
        __syncthreads();
#pragma unroll 1
        for (int n = 0; n < 56; n += 4) {
            scan2_step_load<true, true>(lds, base, n, dst, R1, lt);
            scan2_step_load<true, true>(lds, base, n + 1, dst, R2, lt);
            scan2_step_load<true, true>(lds, base, n + 2, dst, R3, lt);
            scan2_step_load<true, true>(lds, base, n + 3, dst, R0, lt);
        }
        scan2_step_load<true, true>(lds, base, 56, dst, R1, lt);
        scan2_step_load<true, true>(lds, base, 57, dst, R2, lt);
        scan2_step_load<true, true>(lds, base, 58, dst, R3, lt);
        scan2_step_load<true, false>(lds, base, 59, dst, R0, lt);
        scan2_step_load<true, false>(lds, base, 60, dst, R1, lt);
        scan2_step_load<true, false>(lds, base, 61, dst, R2, lt);
        scan2_step_load<true, false>(lds, base, 62, dst, R3, lt);
        scan2_step_load<false, false>(lds, base, 63, dst, R0, lt);
    } else {
        __syncthreads();
#pragma unroll 1
        for (int n = 0; n < 64; ++n) __syncthreads();
    }
}
#undef S2_GLOAD
#undef S2_LSTORE
#undef S2_ULOAD

constexpr int OP_QD = 0, OP_IN = 17408, OP_IMG = 17408 + 9216, OP_PART = 2 * OP_IMG, OP_RSTD = OP_PART + 2048, OP_TILE = OP_RSTD + 256;
DI void opass_load(const Args& a, int unit, u32x4 (&st)[3], bf16x8 (&bs)[4], bf16x8 (&bv)[2], u32x4 (&gg)[2]) {
    const int tid = opaque_tid(), lane = tid & 63, wid = tid >> 6;
    unsigned char* ws = a.ws;
    const int n = unit & 63, h = (unit >> 6) & 3, b = unit >> 8;
    const size_t tok0 = (size_t)b * SEQ + n * 64;
    const unsigned char* ub = ws + WS_R6 + (size_t)unit * DN_UNIT_BYTES;
    st[0] = *(const u32x4*)(ub + 16384 + tid * 16); st[1] = *(const u32x4*)(ub + 16384 + 8192 + tid * 16); st[2] = *(const u32x4*)(ub + 49152 + tid * 16);
    const unsigned char* sb = ws + WS_SB + ((size_t)unit * 8 + wid) * 4096 + lane * 16;
#pragma unroll
    for (int s = 0; s < 4; ++s) bs[s] = *(const bf16x8*)(sb + s * 1024);
    const unsigned char* vb = ub + 57344 + wid * 2048 + lane * 16;
    bv[0] = *(const bf16x8*)vb; bv[1] = *(const bf16x8*)(vb + 1024);
    const bf16_t* pg = (const bf16_t*)(ws + WS_R4) + (tok0 + (tid >> 3)) * 512 + h * 128 + 16 * (tid & 7);
    gg[0] = *(const u32x4*)pg; gg[1] = *(const u32x4*)(pg + 8);
}
DI void opass_stage(LAS unsigned char* img, const u32x4 (&st)[3]) {
    const int tid = opaque_tid();
    *(LAS u32x4*)(img + OP_QD + (tid >> 4) * 272 + (tid & 15) * 16) = st[0];
    *(LAS u32x4*)(img + OP_QD + (32 + (tid >> 4)) * 272 + (tid & 15) * 16) = st[1];
    *(LAS u32x4*)(img + OP_IN + (tid >> 3) * 144 + (tid & 7) * 16) = st[2];
}
DI void opass_compute(const Args& a, LAS unsigned char* lds, const LAS unsigned char* img, int unit, const bf16x8 (&BS)[4], const bf16x8 (&BV)[2], const u32x4 (&gg)[2]) {
    const int tid = opaque_tid(), lane = tid & 63, wid = tid >> 6, fr = lane & 15, fq = lane >> 4;
    unsigned char* ws = a.ws;
    const int n = unit & 63, h = (unit >> 6) & 3, b = unit >> 8;
    const size_t tok0 = (size_t)b * SEQ + n * 64;
    f32x4 Q[4];
    {
        bf16x8 aq[4][4], ai[4][2];
#pragma unroll
        for (int m = 0; m < 4; ++m) {
#pragma unroll
            for (int s = 0; s < 4; ++s) aq[m][s] = *(const LAS bf16x8*)(img + OP_QD + (16 * m + fr) * 272 + 64 * s + 16 * fq);
#pragma unroll
            for (int s = 0; s < 2; ++s) ai[m][s] = *(const LAS bf16x8*)(img + OP_IN + (16 * m + fr) * 144 + 64 * s + 16 * fq);
        }
#pragma unroll
        for (int m = 0; m < 4; ++m) {
            f32x4 q = {0.f, 0.f, 0.f, 0.f};
#pragma unroll
            for (int s = 0; s < 4; ++s) q = mfma16(aq[m][s], BS[s], q);
#pragma unroll
            for (int s = 0; s < 2; ++s) q = mfma16(ai[m][s], BV[s], q);
            Q[m] = q;
        }
    }
    LAS float* part = (LAS float*)(lds + OP_PART);
    LAS float* rstd = (LAS float*)(lds + OP_RSTD);
    LAS unsigned char* tile = lds + OP_TILE;
#pragma unroll
    for (int m = 0; m < 4; ++m)
#pragma unroll
        for (int r = 0; r < 4; ++r) {
            float v = Q[m][r] * Q[m][r];
            v += dppf<0xB1>(v); v += dppf<0x4E>(v); v += dppf<0x141>(v); v += dppf<0x140>(v);
            if (fr == 0) part[wid * 64 + 16 * m + 4 * fq + r] = v;
        }
    __syncthreads();
    if (tid < 64) {
        float sum = 0.f;
#pragma unroll
        for (int w = 0; w < 8; ++w) sum += part[w * 64 + tid];
        rstd[tid] = rsqrtf(sum * (1.0f / 128.0f) + EPS);
    }
    __syncthreads();
    {
        const float nwc = a.in[I_DNNORM][16 * wid + fr];
#pragma unroll
        for (int m = 0; m < 4; ++m) {
            const f32x4 rs4 = *(const LAS f32x4*)(rstd + 16 * m + 4 * fq);
#pragma unroll
            for (int r = 0; r < 4; ++r) *(LAS bf16_t*)(tile + (16 * m + 4 * fq + r) * 272 + 2 * (16 * wid + fr)) = (bf16_t)f2bf(Q[m][r] * rs4[r] * nwc);
        }
    }
    __syncthreads();
    {
        const int token = tid >> 3, g8 = tid & 7;
        const u32x4 y0 = *(const LAS u32x4*)(tile + token * 272 + g8 * 32), y1 = *(const LAS u32x4*)(tile + token * 272 + g8 * 32 + 16);
        const unsigned yw[8] = {y0.x, y0.y, y0.z, y0.w, y1.x, y1.y, y1.z, y1.w}, gw[8] = {gg[0].x, gg[0].y, gg[0].z, gg[0].w, gg[1].x, gg[1].y, gg[1].z, gg[1].w};
        unsigned ow[8];
#pragma unroll
        for (int e = 0; e < 8; ++e) ow[e] = pk2(bflo(yw[e]) * siluf_(bflo(gw[e])), bfhi(yw[e]) * siluf_(bfhi(gw[e])));
        bf16_t* mp = (bf16_t*)(ws + WS_R1) + (tok0 + token) * DM + 512 + h * 128 + 16 * g8;
        *(u32x4*)mp = (u32x4){ow[0], ow[1], ow[2], ow[3]}; *(u32x4*)(mp + 8) = (u32x4){ow[4], ow[5], ow[6], ow[7]};
    }
}
DI void phase_opass(const Args& a, LAS unsigned char* lds, int bid, int G) {
    u32x4 stA[3], stB[3], ggA[2], ggB[2]; bf16x8 bsA[4], bsB[4], bvA[2], bvB[2];
    int u = bid, buf = 0;
    if (u < 1024) opass_load(a, u, stA, bsA, bvA, ggA);
    while (u < 1024) {
        opass_stage(lds + buf * OP_IMG, stA);
        __syncthreads();
        const int un = u + G;
        if (un < 1024) opass_load(a, un, stB, bsB, bvB, ggB);
        opass_compute(a, lds, lds + buf * OP_IMG, u, bsA, bvA, ggA);
#pragma unroll
        for (int i = 0; i < 3; ++i) stA[i] = stB[i];
#pragma unroll
        for (int i = 0; i < 4; ++i) bsA[i] = bsB[i];
        bvA[0] = bvB[0]; bvA[1] = bvB[1]; ggA[0] = ggB[0]; ggA[1] = ggB[1];
        buf ^= 1; u = un;
    }
}

template <int MODE>
DI void phase_tables(const Args& a, int row_lo, int row_hi, int vb, int nvb) {
    const int tid = opaque_tid(), lane = tid & 63, wid = tid >> 6;
    unsigned char* ws = a.ws;
    unsigned char* dn8 = ws + WS_DNT;
    unsigned char* up8 = ws + WS_UPT;
    const float* n2 = a.in[I_N2W];
    f32x4 nw[4];
#pragma unroll
    for (int q = 0; q < 4; ++q) nw[q] = *(const f32x4*)(n2 + 16 * lane + 4 * q) * PEER_SC_D;
    constexpr int NR = MODE == 0 ? 2 : 4;
    for (int e0 = row_lo + vb * 8 + wid; e0 < row_hi; e0 += NR * nvb * 8) {
        f32x4 v[4][4];
#pragma unroll
        for (int it = 0; it < 4; ++it) {
            const int k = MODE == 0 ? (it >> 1) : it, which = MODE == 0 ? (it & 1) : (MODE == 2);
            const int e = e0 + k * nvb * 8, ec = e < row_hi ? e : e0;
#pragma unroll
            for (int q = 0; q < 4; ++q) v[it][q] = ((const f32x4*)((which ? a.in[I_EUP] : a.in[I_EDOWN]) + (size_t)ec * DM + 16 * lane))[q];
        }
#pragma unroll
        for (int it = 0; it < 4; ++it) {
            const int k = MODE == 0 ? (it >> 1) : it, which = MODE == 0 ? (it & 1) : (MODE == 2);
            const int e = e0 + k * nvb * 8;
            u32x4 o;
#pragma unroll
            for (int q = 0; q < 4; ++q) {
                const f32x4 x = which ? v[it][q] * PEER_SC_U : v[it][q] * nw[q];
                unsigned p = __builtin_amdgcn_cvt_pk_fp8_f32(x[0], x[1], 0, false);
                p = __builtin_amdgcn_cvt_pk_fp8_f32(x[2], x[3], p, true);
                o[q] = p;
            }
            if (e < row_hi) *(u32x4*)((which ? up8 : dn8) + (size_t)(lane >> 3) * PEER_SLICE + (size_t)e * 128 + (lane & 7) * 16) = o;
        }
    }
}

DI void ce(float& hi, float& lo) { const float a = hi, b = lo; hi = fmaxf(a, b); lo = fminf(a, b); }
DI void sort16_desc(float (&x)[16]) {
    ce(x[0], x[13]); ce(x[1], x[12]); ce(x[2], x[15]); ce(x[3], x[14]); ce(x[4], x[8]); ce(x[5], x[6]); ce(x[7], x[11]); ce(x[9], x[10]);
    ce(x[0], x[5]); ce(x[1], x[7]); ce(x[2], x[9]); ce(x[3], x[4]); ce(x[6], x[13]); ce(x[8], x[14]); ce(x[10], x[15]); ce(x[11], x[12]);
    ce(x[0], x[1]); ce(x[2], x[3]); ce(x[4], x[5]); ce(x[6], x[8]); ce(x[7], x[9]); ce(x[10], x[11]); ce(x[12], x[13]); ce(x[14], x[15]);
    ce(x[0], x[2]); ce(x[1], x[3]); ce(x[4], x[10]); ce(x[5], x[11]); ce(x[6], x[7]); ce(x[8], x[9]); ce(x[12], x[14]); ce(x[13], x[15]);
    ce(x[1], x[2]); ce(x[3], x[12]); ce(x[4], x[6]); ce(x[5], x[7]); ce(x[8], x[10]); ce(x[9], x[11]); ce(x[13], x[14]);
    ce(x[1], x[4]); ce(x[2], x[6]); ce(x[5], x[8]); ce(x[7], x[10]); ce(x[9], x[13]); ce(x[11], x[14]);
    ce(x[2], x[4]); ce(x[3], x[6]); ce(x[9], x[12]); ce(x[11], x[13]);
    ce(x[3], x[5]); ce(x[6], x[8]); ce(x[7], x[9]); ce(x[10], x[12]);
    ce(x[3], x[4]); ce(x[5], x[6]); ce(x[7], x[8]); ce(x[9], x[10]); ce(x[11], x[12]);
    ce(x[6], x[7]); ce(x[8], x[9]);
}
DI void bmerge16_desc(float (&x)[16]) {
#pragma unroll
    for (int j = 8; j > 0; j >>= 1)
#pragma unroll
        for (int i = 0; i < 16; ++i) { const int l = i ^ j; if (l > i) ce(x[i], x[l]); }
}
DI void merge_top16(float (&x)[16], const float (&y)[16]) {
#pragma unroll
    for (int i = 0; i < 16; ++i) x[i] = fmaxf(x[i], y[15 - i]);
    bmerge16_desc(x);
}
struct CandTab { int i[64]; int j[64]; };
constexpr CandTab make_cand() {
    CandTab t{}; int n = 0;
    for (int i = 0; i < 16; ++i) for (int j = 0; j < 16; ++j) if ((i + 1) * (j + 1) <= 16) { t.i[n] = i; t.j[n] = j; ++n; }
    for (; n < 64; ++n) { t.i[n] = -1; t.j[n] = -1; }
    return t;
}
constexpr CandTab CAND = make_cand();

DI void topk_half(const bf16_t* qrow  , const LAS unsigned char* keys  , int r32, int hh, float (&top)[16]) {
    bf16x8 bq[8];
#pragma unroll
    for (int s = 0; s < 8; ++s) bq[s] = *(const bf16x8*)(qrow + 16 * s + 8 * hh);
    float run[16];
#pragma unroll
    for (int mt = 0; mt < 4; ++mt) {
        f32x16 acc;
#pragma unroll
        for (int e = 0; e < 16; ++e) acc[e] = 0.f;
#pragma unroll
        for (int s = 0; s < 8; ++s) { const bf16x8 A = *(const LAS bf16x8*)(keys + (32 * mt + r32) * 272 + 32 * s + 16 * hh); acc = mfma32(A, bq[s], acc); }
        asm volatile("" ::: "memory");
        float cur[16];
#pragma unroll
        for (int e = 0; e < 16; ++e) {
            const unsigned key = 32 * mt + (e & 3) + 8 * (e >> 2) + 4 * hh;
            cur[e] = __uint_as_float((__float_as_uint(acc[e]) & ~127u) | key);
        }
        sort16_desc(cur);
        if (mt == 0) {
#pragma unroll
            for (int e = 0; e < 16; ++e) run[e] = cur[e];
        } else merge_top16(run, cur);
        asm volatile("" : "+v"(run[0]), "+v"(run[1]), "+v"(run[2]), "+v"(run[3]), "+v"(run[4]), "+v"(run[5]), "+v"(run[6]), "+v"(run[7]));
        asm volatile("" : "+v"(run[8]), "+v"(run[9]), "+v"(run[10]), "+v"(run[11]), "+v"(run[12]), "+v"(run[13]), "+v"(run[14]), "+v"(run[15]));
    }
    float oth[16];
#pragma unroll
    for (int e = 0; e < 16; ++e) oth[e] = __shfl_xor(run[e], 32);
    merge_top16(run, oth);
#pragma unroll
    for (int e = 0; e < 16; ++e) top[e] = run[e];
}

DI void phase_topk(const Args& a, LAS unsigned char* lds, int bid, int G) {
    const int wid = threadIdx.x >> 6;
    unsigned char* ws = a.ws;
    const bf16_t* qry = (const bf16_t*)(ws + WS_QRY);
    const bf16_t* keys = (const bf16_t*)(ws + WS_KEYS);
    const float* rstd2 = (const float*)(ws + WS_RSTD2);
    int* idx_out = (int*)(ws + WS_IDX);
    float* gate_out = (float*)(ws + WS_GATES);
    LAS unsigned* lw = (LAS unsigned*)(lds + 2 * 128 * 272 + wid * 8192);
    __syncthreads();
    for (int c = threadIdx.x; c < 2 * 128 * 16; c += NTHR) {
        const int row = c >> 4, ch = c & 15;
        *(LAS u32x4*)(lds + row * 272 + ch * 16) = *(const u32x4*)(keys + row * 128 + ch * 8);
    }
    __syncthreads();
    const bool local_map = (G == 256);
    for (int it_ = 0; it_ < (local_map ? 2 : (512 * 8 - 1 - (bid * 8 + wid)) / (G * 8) + 1); ++it_) {
        const int item = local_map ? ((2 * bid + it_) * 8 + wid) : (bid * 8 + wid + it_ * G * 8);
        if (item >= 512 * 8) break;
        int lane = threadIdx.x & 63;
        asm volatile("" : "+v"(lane));
        const int r32 = lane & 31, hh = lane >> 5;
        const int tg = item >> 3, h = item & 7, tok = tg * 32 + r32;
        float v1[16], v2[16];
        topk_half(qry + (size_t)tok * 2048 + h * 256, lds, r32, hh, v1);
        topk_half(qry + (size_t)tok * 2048 + h * 256 + 128, lds + 128 * 272, r32, hh, v2);
#pragma unroll
        for (int m = 0; m < 16; ++m) { lw[m * 64 + lane] = __float_as_uint(v1[m]); lw[(16 + m) * 64 + lane] = __float_as_uint(v2[m]); }
        float ca[16], cb[16];
#pragma unroll
        for (int m = 0; m < 32; ++m) {
            constexpr float NEG = -3.0e38f;
            float s0 = NEG, s1 = NEG;
            const int i0 = CAND.i[m], j0 = CAND.j[m], i1 = CAND.i[32 + m], j1 = CAND.j[32 + m];
            if (i0 >= 0) s0 = __uint_as_float((__float_as_uint(v1[i0 >= 0 ? i0 : 0] + v2[j0 >= 0 ? j0 : 0]) & ~255u) | (unsigned)(i0 * 16 + j0));
            if (i1 >= 0) s1 = __uint_as_float((__float_as_uint(v1[i1 >= 0 ? i1 : 0] + v2[j1 >= 0 ? j1 : 0]) & ~255u) | (unsigned)(i1 * 16 + j1));
            const float s = hh ? s1 : s0;
            if (m < 16) ca[m] = s; else cb[m - 16] = s;
        }
        sort16_desc(ca); sort16_desc(cb); merge_top16(ca, cb);
#pragma unroll
        for (int e = 0; e < 16; ++e) cb[e] = __shfl_xor(ca[e], 32);
        merge_top16(ca, cb);
        const float rs = rsqrtf(rstd2[tok] * (1.0f / DM) + EPS);
        float ex[16], sum = 0.f;
#pragma unroll
        for (int e = 0; e < 16; ++e) { ex[e] = __expf((ca[e] - ca[0]) * rs); sum += ex[e]; }
        const float inv = 1.0f / sum;
        int idx[16];
#pragma unroll
        for (int e = 0; e < 16; ++e) {
            const unsigned code = __float_as_uint(ca[e]) & 255u;
            const unsigned i1 = lw[(code >> 4) * 64 + lane] & 127u, i2 = lw[(16 + (code & 15)) * 64 + lane] & 127u;
            idx[e] = (int)(i1 * 128 + i2);
        }
        if (hh == 0) {
#pragma unroll
            for (int k = 0; k < 4; ++k) *(i32x4*)(idx_out + (size_t)tok * 128 + h * 16 + 4 * k) = (i32x4){idx[4 * k], idx[4 * k + 1], idx[4 * k + 2], idx[4 * k + 3]};
        } else {
#pragma unroll
            for (int k = 0; k < 4; ++k) *(f32x4*)(gate_out + (size_t)tok * 128 + h * 16 + 4 * k) = (f32x4){ex[4 * k] * inv, ex[4 * k + 1] * inv, ex[4 * k + 2] * inv, ex[4 * k + 3] * inv};
        }
    }
}

constexpr int PG_IROW = 264;
constexpr int PG_WROW = 528;
constexpr int PG_WOFF = 64 * PG_IROW;
DI f32x2 cvt2(unsigned w, bool hi) { return hi ? __builtin_amdgcn_cvt_pk_f32_fp8(w, true) : __builtin_amdgcn_cvt_pk_f32_fp8(w, false); }
DI float dot16_fp8(const f32x2 (&h)[8], const u32x4 v) {
    f32x2 acc = h[0] * cvt2(v.x, false);
    acc += h[1] * cvt2(v.x, true);
    acc += h[2] * cvt2(v.y, false);
    acc += h[3] * cvt2(v.y, true);
    acc += h[4] * cvt2(v.z, false);
    acc += h[5] * cvt2(v.z, true);
    acc += h[6] * cvt2(v.w, false);
    acc += h[7] * cvt2(v.w, true);
    return acc[0] + acc[1];
}
DI void axpy16_fp8(f32x2 (&acc)[8], const float w, const u32x4 v) {
    const f32x2 w2 = {w, w};
    acc[0] += w2 * cvt2(v.x, false); acc[1] += w2 * cvt2(v.x, true);
    acc[2] += w2 * cvt2(v.y, false); acc[3] += w2 * cvt2(v.y, true);
    acc[4] += w2 * cvt2(v.z, false); acc[5] += w2 * cvt2(v.z, true);
    acc[6] += w2 * cvt2(v.w, false); acc[7] += w2 * cvt2(v.w, true);
}
template <int CTRL> DI float dpp_f(float v) { return __int_as_float(__builtin_amdgcn_update_dpp(0, __float_as_int(v), CTRL, 0xf, 0xf, true)); }
DI float sum8(float v) {
    v += dpp_f<0xB1>(v);
    v += dpp_f<0x4E>(v);
    v += dpp_f<0x141>(v);
    return v;
}
#define PG_LOAD8(dst, base, iw) do { _Pragma("unroll") for (int m_ = 0; m_ < 8; ++m_) { \
        const unsigned e_ = ((m_ & 1) ? ((iw)[m_ >> 1] >> 16) : ((iw)[m_ >> 1] & 0xffffu)); \
        dst[m_] = __builtin_amdgcn_raw_buffer_load_b128(base, e_ * 128u + joff, soff, 0); } } while (0)
DI void phase_gather(const Args& a, LAS unsigned char* lds, int bid, int G) {
    const int wid = threadIdx.x >> 6;
    unsigned char* ws = a.ws;
    const bf16_t* h2b = (const bf16_t*)(ws + WS_H2B);
    const __amdgpu_buffer_rsrc_t rs_dn = __builtin_amdgcn_make_buffer_rsrc((void*)(ws + WS_DNT), 0, 8 * (int)PEER_SLICE, 0x00020000);
    const __amdgpu_buffer_rsrc_t rs_up = __builtin_amdgcn_make_buffer_rsrc((void*)(ws + WS_UPT), 0, 8 * (int)PEER_SLICE, 0x00020000);
    const int* idxp = (const int*)(ws + WS_IDX);
    const float* gatep = (const float*)(ws + WS_GATES);
    const float* rstd2 = (const float*)(ws + WS_RSTD2);
    for (int tile = bid; tile < 256; tile += G) {
        int lane = threadIdx.x & 63;
        asm volatile("" : "+v"(lane));
        const int g = lane >> 3, j = lane & 7, tl = wid * 8 + g, tok = tile * 64 + tl;
        __syncthreads();
        for (int e = threadIdx.x; e < 2048; e += NTHR) {
            const i32x4 v = *(const i32x4*)(idxp + (size_t)tile * 8192 + 4 * e);
            u32x2 w; w.x = (unsigned)v[0] | ((unsigned)v[1] << 16); w.y = (unsigned)v[2] | ((unsigned)v[3] << 16);
            *(LAS u32x2*)(lds + (e >> 5) * PG_IROW + (e & 31) * 8) = w;
        }
        __syncthreads();
        const LAS unsigned char* irow = lds + tl * PG_IROW;
        LAS unsigned char* wrow = lds + PG_WOFF + tl * PG_WROW;
#ifndef GD_REPS
#define GD_REPS 1
#endif
#pragma unroll 1
        for (int hp_ = 0; hp_ < 2 * GD_REPS; ++hp_) { const int hp = hp_ & 1;
            float p[64];
#pragma unroll
            for (int k = 0; k < 64; ++k) p[k] = 0.f;
            const LAS unsigned char* ir = irow + hp * 128;
#pragma unroll 1
            for (int c = 0; c < 8; ++c) {
                f32x2 hf[8];
                {
                    const u32x4* hp_ = (const u32x4*)(h2b + (size_t)tok * DM + 128 * c + 16 * j);
                    const u32x4 h0 = hp_[0], h1 = hp_[1];
                    hf[0] = (f32x2){bflo(h0.x), bfhi(h0.x)}; hf[1] = (f32x2){bflo(h0.y), bfhi(h0.y)}; hf[2] = (f32x2){bflo(h0.z), bfhi(h0.z)}; hf[3] = (f32x2){bflo(h0.w), bfhi(h0.w)};
                    hf[4] = (f32x2){bflo(h1.x), bfhi(h1.x)}; hf[5] = (f32x2){bflo(h1.y), bfhi(h1.y)}; hf[6] = (f32x2){bflo(h1.z), bfhi(h1.z)}; hf[7] = (f32x2){bflo(h1.w), bfhi(h1.w)};
                }
                const __amdgpu_buffer_rsrc_t sb = rs_dn; const unsigned joff = j * 16; const int soff = c * (int)PEER_SLICE;
                u32x4 va[8], vb[8];
                { const u32x4 iw = *(const LAS u32x4*)(ir); PG_LOAD8(va, sb, iw); }
#pragma unroll
                for (int bt = 0; bt < 8; bt += 2) {
                    { const u32x4 iw = *(const LAS u32x4*)(ir + (bt + 1) * 16); PG_LOAD8(vb, sb, iw); }
#pragma unroll
                    for (int m = 0; m < 8; ++m) p[8 * bt + m] += dot16_fp8(hf, va[m]);
                    if (bt + 2 < 8) { const u32x4 iw = *(const LAS u32x4*)(ir + (bt + 2) * 16); PG_LOAD8(va, sb, iw); }
#pragma unroll
                    for (int m = 0; m < 8; ++m) p[8 * (bt + 1) + m] += dot16_fp8(hf, vb[m]);
                }
            }
            const float rs = rsqrtf(rstd2[tok] * (1.0f / DM) + EPS) * (1.0f / PEER_SC_D);
#pragma unroll
            for (int bt = 0; bt < 8; ++bt) {
                float mine = 0.f;
#pragma unroll
                for (int m = 0; m < 8; ++m) { const float s_ = sum8(p[8 * bt + m]); mine = (j == m) ? s_ : mine; }
                const float x = mine * rs;
                const float gt = gatep[(size_t)tok * 128 + 64 * hp + 8 * bt + j];
                const float w = gt * 0.5f * x * (1.0f + erff(x * 0.70710678118654752f)) * (1.0f / PEER_SC_U);
                *(LAS float*)(wrow + (64 * hp + 8 * bt + j) * 4) = w;
            }
        }
        int lane2 = threadIdx.x & 63;
        asm volatile("" : "+v"(lane2));
        const int g2 = lane2 >> 3, j2 = lane2 & 7, tl2 = wid * 8 + g2, tok2 = tile * 64 + tl2;
        const LAS unsigned char* irow2 = lds + tl2 * PG_IROW;
        const LAS unsigned char* wrow2 = lds + PG_WOFF + tl2 * PG_WROW;
#pragma unroll 1
        for (int c = 0; c < 8; ++c) {
            f32x2 acc[8];
#pragma unroll
            for (int i = 0; i < 8; ++i) acc[i] = (f32x2){0.f, 0.f};
            const __amdgpu_buffer_rsrc_t sb = rs_up; const unsigned joff = j2 * 16; const int soff = c * (int)PEER_SLICE;
            u32x4 va[8], vb[8];
            { const u32x4 iw = *(const LAS u32x4*)(irow2); PG_LOAD8(va, sb, iw); }
#pragma unroll 1
            for (int bt = 0; bt < 16; bt += 2) {
                { const u32x4 iw = *(const LAS u32x4*)(irow2 + (bt + 1) * 16); PG_LOAD8(vb, sb, iw); }
                { const f32x4 w0 = *(const LAS f32x4*)(wrow2 + bt * 32), w1 = *(const LAS f32x4*)(wrow2 + bt * 32 + 16);
#pragma unroll
                  for (int m = 0; m < 4; ++m) { axpy16_fp8(acc, w0[m], va[m]); }
#pragma unroll
                  for (int m = 0; m < 4; ++m) { axpy16_fp8(acc, w1[m], va[4 + m]); } }
                if (bt + 2 < 16) { const u32x4 iw = *(const LAS u32x4*)(irow2 + (bt + 2) * 16); PG_LOAD8(va, sb, iw); }
                { const f32x4 w0 = *(const LAS f32x4*)(wrow2 + (bt + 1) * 32), w1 = *(const LAS f32x4*)(wrow2 + (bt + 1) * 32 + 16);
#pragma unroll
                  for (int m = 0; m < 4; ++m) { axpy16_fp8(acc, w0[m], vb[m]); }
#pragma unroll
                  for (int m = 0; m < 4; ++m) { axpy16_fp8(acc, w1[m], vb[4 + m]); } }
            }
            const u32x4* xp = (const u32x4*)(h2b + (size_t)tok2 * DM + 128 * c + 16 * j2);
            const u32x4 x0 = xp[0], x1v = xp[1];
            f32x4* op = (f32x4*)(a.out + (size_t)tok2 * DM + 128 * c + 16 * j2);
            op[0] = (f32x4){bflo(x0.x) + acc[0][0], bfhi(x0.x) + acc[0][1], bflo(x0.y) + acc[1][0], bfhi(x0.y) + acc[1][1]};
            op[1] = (f32x4){bflo(x0.z) + acc[2][0], bfhi(x0.z) + acc[2][1], bflo(x0.w) + acc[3][0], bfhi(x0.w) + acc[3][1]};
            op[2] = (f32x4){bflo(x1v.x) + acc[4][0], bfhi(x1v.x) + acc[4][1], bflo(x1v.y) + acc[5][0], bfhi(x1v.y) + acc[5][1]};
            op[3] = (f32x4){bflo(x1v.z) + acc[6][0], bfhi(x1v.z) + acc[6][1], bflo(x1v.w) + acc[7][0], bfhi(x1v.w) + acc[7][1]};
        }
    }
}

constexpr int N_PHASES = 9;
__global__ void __launch_bounds__(NTHR, 2) fwd(Args a) {
    extern __shared__ __attribute__((aligned(16))) unsigned char lds_raw[];
    LAS unsigned char* lds = (LAS unsigned char*)lds_raw;
    const int bid = blockIdx.x, G = gridDim.x;
    unsigned char* ws = a.ws;
    const int lo = a.ph_lo, hi = a.ph_hi;
    XcdBarrier xb;
    if (hi - lo > 1) {
        LAS unsigned* st = (LAS unsigned*)(lds + LDS_BYTES - 16);
        if (threadIdx.x == 0) { st[0] = 0u; st[1] = 0u; }
        __syncthreads();
        xb = xcd_barrier_post((unsigned*)(ws + WS_BAR), (volatile LAS unsigned*)st);
    }
#ifdef ONLY_PHASE
#define IN(k) ((k) == ONLY_PHASE)
#else
#define IN(k) (lo <= (k) && (k) < hi)
#endif
#define SEAM(k) do { if (IN(k) && IN((k) + 1)) xcd_barrier(xb); } while (0)
    const bool pgrp = (G == 256);
    const int pg_pm = ((bid >> 5) << 3) + (bid & 7), pg_r = (bid >> 3) & 3, pg_tile = pgrp ? 4 * pg_pm + pg_r : bid;
#define GSEAM(k, s) do { if (IN(k) && IN((k) + 1)) { if (pgrp) group_sync((unsigned*)(ws + WS_BAR) + GS_WORD0 + ((s) * 64 + pg_pm) * 32, 4u, (unsigned*)(ws + WS_BAR)); else xcd_barrier(xb); } } while (0)
#ifndef REPEAT_MASK
#define REPEAT_MASK 0
#endif
#define REPS(k) (((REPEAT_MASK >> (k)) & 1) ? 2 : 1)
    for (int rep = 0; rep < REPS(0); ++rep) { if (IN(0)) { phase_prep(a, lds, bid, G);
#ifdef P0_TWICE
        __syncthreads(); phase_prep(a, lds, bid, G);
#endif
    }
    SEAM(0); }
    for (int rep = 0; rep < REPS(1); ++rep) { if (IN(1)) { pg8::EpiProj e{(bf16_t*)(ws + WS_R2), (bf16_t*)(ws + WS_R3), (bf16_t*)(ws + WS_R4), (const float*)(ws + WS_RSTD1)};
                 pg8::StaticOrder so; so.init(NTOK, NPROJ, G, bid);
                 pg8::gemm_phase<pg8::EpiProj, pg8::StaticOrder, true, true>(lds, pg8::Gemm{(const bf16_t*)(ws + WS_R1), (const bf16_t*)(ws + WS_WINT), NTOK, NPROJ, DM}, so, e);
                 if (UP_EARLY > 0 && G == 256 && bid >= 192) phase_tables<2>(a, 0, UP_EARLY, bid - 192, 64); }
    SEAM(1); }
    for (int rep = 0; rep < REPS(2); ++rep) { if (IN(2)) {
#ifndef QK_REPS
#define QK_REPS 1
#endif
#ifndef DP_REPS
#define DP_REPS 1
#endif
        for (int rr = 0; rr < QK_REPS; ++rr) phase_qknorm(a, bid, G);
        for (int rr = 0; rr < DP_REPS; ++rr) phase_dnprep(a, lds, bid, G); }
    SEAM(2); }
    for (int rep = 0; rep < REPS(3); ++rep) { if (IN(3)) {
#ifndef SCAN_REPS
#define SCAN_REPS 1
#endif
#ifndef ATTN_REPS
#define ATTN_REPS 1
#endif
        if (G >= 128) {
            for (int rr = 0; rr < SCAN_REPS; ++rr) if (bid < S2_NBLK) { const int k = bid >> 3; scan2_unit(a, lds, (k % S2_PARTS) * 16 + (bid & 7) + 8 * (k / S2_PARTS)); }
            for (int rr = 0; rr < ATTN_REPS; ++rr) if (bid >= S2_NBLK) { for (int u = bid - S2_NBLK; u < 512; u += G - S2_NBLK) attn_unit(a, lds, u); }
            const int up_lo = G == 256 ? UP_EARLY : 0;
            if (bid >= S2_NBLK) { if (up_lo > 0) phase_tables<1>(a, 0, up_lo, bid - S2_NBLK, G - S2_NBLK);
                                  phase_tables<0>(a, up_lo, TAB_SPLIT, bid - S2_NBLK, G - S2_NBLK); }
            else if (TAB_SPLIT < 16384) phase_tables<0>(a, TAB_SPLIT, 16384, bid, S2_NBLK);
        } else {
            for (int u = bid; u < S2_NBLK; u += G) scan2_unit(a, lds, u);
            for (int u = bid; u < 512; u += G) attn_unit(a, lds, u);
            phase_tables<0>(a, 0, 16384, bid, G);
        }
    }
    SEAM(3); }
    for (int rep = 0; rep < REPS(4); ++rep) { if (IN(4)) {
        phase_opass(a, lds, bid, G);
    }
    SEAM(4); }
    for (int rep = 0; rep < REPS(5); ++rep) { if (IN(5)) { pg8::EpiOut e{a.in[I_X], a.out, (bf16_t*)(ws + WS_H2B), (float*)(ws + WS_RSTD2)};
                 pg8::FlexOrder so; so.so.init(NTOK, DM, G, bid); so.panel = pgrp ? pg_pm : -1; so.pn0 = pg_r; so.n = 1;
                 pg8::gemm_phase<pg8::EpiOut, pg8::FlexOrder, true, true>(lds, pg8::Gemm{(const bf16_t*)(ws + WS_R1), (const bf16_t*)(ws + WS_WOUTT), NTOK, DM, DM}, so, e); }
    GSEAM(5, 0); }
    for (int rep = 0; rep < REPS(6); ++rep) { if (IN(6)) {
                 __syncthreads();
                 pg8::EpiQry e{(bf16_t*)(ws + WS_QRY)};
                 pg8::FlexOrder so; so.so.init(NTOK, 2048, G, bid); so.panel = pgrp ? pg_pm : -1; so.pn0 = 2 * pg_r; so.n = 2;
                 pg8::gemm_phase<pg8::EpiQry, pg8::FlexOrder, true, true>(lds, pg8::Gemm{(const bf16_t*)(ws + WS_H2B), (const bf16_t*)(ws + WS_WQT), NTOK, 2048, DM}, so, e); }
    GSEAM(6, 1); }
    for (int rep = 0; rep < REPS(7); ++rep) { if (IN(7)) phase_topk(a, lds, pg_tile, G);
    if (G == 256 && IN(7) && IN(8)) { asm volatile("s_waitcnt vmcnt(0)" ::: "memory"); __syncthreads(); }
    else SEAM(7); }
    if (IN(8)) phase_gather(a, lds, pg_tile, G);
}

extern "C" void kernel_launch(void* const* d_in, const int* in_sizes, int n_in, void* d_out, int out_size, void* d_ws, size_t ws_size, hipStream_t stream) {
    static int grid = 0;
    if (grid == 0) {
        if (n_in != 17 || out_size != NTOK * DM || ws_size < WS_END) { fprintf(stderr, "kernel_launch: unexpected shapes (n_in %d out %d ws %zu)\n", n_in, out_size, ws_size); grid = -1; return; }
        int dev = 0, cus = 0, per_cu = 0;
        if (hipGetDevice(&dev) != hipSuccess || hipDeviceGetAttribute(&cus, hipDeviceAttributeMultiprocessorCount, dev) != hipSuccess) { grid = -1; return; }
        if (hipFuncSetAttribute((const void*)fwd, hipFuncAttributeMaxDynamicSharedMemorySize, LDS_BYTES) != hipSuccess) { fprintf(stderr, "kernel_launch: hipFuncSetAttribute failed\n"); grid = -1; return; }
        if (hipOccupancyMaxActiveBlocksPerMultiprocessor(&per_cu, (const void*)fwd, NTHR, LDS_BYTES) != hipSuccess || per_cu < 1) { fprintf(stderr, "kernel_launch: occupancy query says %d\n", per_cu); }
        (void)hipGetLastError();
        grid = cus;
    }
    if (grid < 0) return;
    Args a{};
    for (int i = 0; i < 17; ++i) a.in[i] = (const float*)d_in[i];
    a.out = (float*)d_out; a.ws = (unsigned char*)d_ws;
#if N_LAUNCH_PER_PHASE
    for (int p = 0; p < N_PHASES; ++p) { a.ph_lo = p; a.ph_hi = p + 1; hipLaunchKernelGGL(fwd, dim3(grid), dim3(NTHR), LDS_BYTES, stream, a); }
#else
    (void)hipMemsetAsync((unsigned char*)d_ws + WS_BAR, 0, GS_WORDS * 4, stream);
    a.ph_lo = 0; a.ph_hi = N_PHASES;
    hipLaunchKernelGGL(fwd, dim3(grid), dim3(NTHR), LDS_BYTES, stream, a);
#endif
}
```
